# Optimizing an MI355X kernel written in HIP

```python
import jax
import jax.numpy as jnp
from jax import lax
import numpy as np

D_MODEL = 1024
BATCH = 8
SEQ = 2048
DEPTH = 4

GRID_W = 64
CTX_LEN = 256
N_EVEN = (DEPTH + 1) // 2
N_ODD = DEPTH // 2
N_MOD = 6
EPS = 1e-6
NEG_BIG = -1e9
LB_MIN = 1e-30

HG_WIDTH = D_MODEL // 2
HG_HEAD_DIM = 128
HG_HEADS = HG_WIDTH // HG_HEAD_DIM
HG_CHUNK = 64
RG_WIDTH = D_MODEL - HG_WIDTH
RG_BLOCKS = 8
RG_BLOCK = RG_WIDTH // RG_BLOCKS
RG_CONV = 4
RG_C = 8.0
EVEN_SPLITS = (HG_WIDTH, HG_WIDTH, HG_WIDTH, HG_WIDTH, HG_WIDTH, RG_WIDTH, RG_WIDTH)
EVEN_IN = 5 * HG_WIDTH + 2 * RG_WIDTH
NA_HEADS = 16
NA_HEAD_DIM = D_MODEL // NA_HEADS
NA_KR = 8
NA_KC = 16
NA_QB = 16
NA_CB = NA_QB + NA_KC
D_FF = 2816
N_EXPERTS = 8
TOP_K = 2
D_FF_EXPERT = 2816

kernel_name = "hybrid_hgrn2_rglru_natten_moe_dit"


def _rmsnorm(x, g):
    xf = x.astype(jnp.float32)
    y = xf * lax.rsqrt(jnp.mean(xf * xf, axis=-1, keepdims=True) + EPS)
    return (y * g.astype(jnp.float32)).astype(x.dtype)


def _modulate(x, g, shift, scale):
    return _rmsnorm(x, g) * (1 + scale) + shift


def _adaln(cond, w_mod, b_mod):
    return jnp.split(jax.nn.silu(cond) @ w_mod + b_mod, N_MOD, axis=-1)


def _swiglu(x, w1, w3, w2):
    return (jax.nn.silu(x @ w1) * (x @ w3)) @ w2


def _moe(x, w_router, w1, w3, w2):
    logits = (x @ w_router).astype(jnp.float32)
    top_v, top_i = lax.top_k(logits, TOP_K)
    top_w = jax.nn.softmax(top_v, axis=-1)
    gates = jnp.einsum('btk,btke->bte', top_w,
                       jax.nn.one_hot(top_i, N_EXPERTS, dtype=jnp.float32)).astype(x.dtype)
    y = gates[..., 0:1] * _swiglu(x, w1[0], w3[0], w2[0])
    for e in range(1, N_EXPERTS):
        y = y + gates[..., e:e + 1] * _swiglu(x, w1[e], w3[e], w2[e])
    return y


def _flip(a):
    return jnp.flip(a, axis=1)


def _prefix_scan(scan_fn, ctx_in, lat_in, reverse):
    if reverse:
        ctx_in = [_flip(a) for a in ctx_in]
        lat_in = [_flip(a) for a in lat_in]
    o_c, s_c = scan_fn(*ctx_in, None)
    o_l, _ = scan_fn(*lat_in, s_c)
    if reverse:
        o_c, o_l = _flip(o_c), _flip(o_l)
    return o_c, o_l


def _gla_chunk_scan(q, k, v, logf, s0):
    B, T, H, K = q.shape
    V = v.shape[-1]
    n = T // HG_CHUNK
    if s0 is None:
        s0 = jnp.zeros((B, H, K, V), jnp.float32)

    def to_chunks(a):
        return a.reshape(B, n, HG_CHUNK, H, a.shape[-1]).transpose(1, 0, 3, 2, 4)

    tri = np.tril(np.ones((HG_CHUNK, HG_CHUNK), dtype=bool))[:, :, None]

    def step(s, inp):
        qc, kc, vc, gc = inp
        b = jnp.cumsum(gc, axis=2)
        o_inter = jnp.einsum('bhtk,bhkv->bhtv', qc * jnp.exp(b), s)
        diff = jnp.where(tri, b[:, :, :, None, :] - b[:, :, None, :, :], NEG_BIG)
        attn = jnp.einsum('bhtk,bhtsk,bhsk->bhts', qc, jnp.exp(diff), kc)
        o = o_inter + jnp.einsum('bhts,bhsv->bhtv', attn, vc)
        b_last = b[:, :, -1:, :]
        s_new = (jnp.exp(b_last[:, :, 0, :])[..., None] * s
                 + jnp.einsum('bhsk,bhsv->bhkv', kc * jnp.exp(b_last - b), vc))
        return s_new, o

    s_fin, o = lax.scan(step, s0, (to_chunks(q), to_chunks(k), to_chunks(v), to_chunks(logf)))
    return o.transpose(1, 0, 3, 2, 4).reshape(B, T, H, V), s_fin


def _linear_scan(a, b, h0):
    if h0 is not None:
        b = b.at[:, 0].add(a[:, 0] * h0)
    _, h = lax.associative_scan(lambda l, r: (l[0] * r[0], r[0] * l[1] + r[1]), (a, b), axis=1)
    return h, h[:, -1]


def _hg_heads(a):
    return a.astype(jnp.float32).reshape(a.shape[:2] + (HG_HEADS, HG_HEAD_DIM))


def _hg_gates(z, lb):
    z = z.astype(jnp.float32)
    k = (1 - lb) * jax.nn.sigmoid(-z)
    logf = jnp.logaddexp(jnp.log(jnp.maximum(lb, LB_MIN)), jnp.log1p(-lb) + jax.nn.log_sigmoid(z))
    return _hg_heads(k), _hg_heads(logf)


def _dwconv_centred(x, w, b):
    left = RG_CONV // 2
    y = lax.conv_general_dilated(x, w[:, None, :], window_strides=(1,),
                                 padding=[(left, RG_CONV - 1 - left)],
                                 dimension_numbers=('NWC', 'WIO', 'NWC'),
                                 feature_group_count=x.shape[-1])
    return y + b


def _blockdiag(x, w, b):
    xb = x.reshape(x.shape[:-1] + (RG_BLOCKS, RG_BLOCK))
    return jnp.einsum('btni,nij->btnj', xb, w).reshape(x.shape) + b


def _rglru_coeffs(xc, wa, ba, wx, bx, lam):
    xf = xc.astype(jnp.float32)
    r = jax.nn.sigmoid(_blockdiag(xf, wa, ba))
    ig = jax.nn.sigmoid(_blockdiag(xf, wx, bx))
    log_a = RG_C * r * jax.nn.log_sigmoid(lam.astype(jnp.float32))
    return jnp.exp(log_a), jnp.sqrt(jnp.maximum(-jnp.expm1(2 * log_a), 0.0)) * (ig * xf)


def _even_mixer(u_ctx, u_lat, w_in, w_out, lb, onorm_g, conv_w, conv_b,
                wa, ba, wx, bx, lam, with_ctx_out):
    f32 = jnp.float32
    cuts = [int(v) for v in np.cumsum(EVEN_SPLITS)[:-1]]
    pc = jnp.split(u_ctx @ w_in, cuts, axis=-1)
    pl = jnp.split(u_lat @ w_in, cuts, axis=-1)
    hq = [_hg_heads(jax.nn.silu(p[0])) for p in (pc, pl)]
    hv = [_hg_heads(p[3]) for p in (pc, pl)]
    xr = [_dwconv_centred(p[5], conv_w, conv_b) for p in (pc, pl)]
    hg_c = hg_l = rg_c = rg_l = 0.0
    for d in range(2):
        kc, lfc = _hg_gates(pc[1 + d], lb[d])
        kl, lfl = _hg_gates(pl[1 + d], lb[d])
        o_c, o_l = _prefix_scan(_gla_chunk_scan, (hq[0], kc, hv[0], lfc),
                                (hq[1], kl, hv[1], lfl), d == 1)
        hg_c, hg_l = hg_c + o_c, hg_l + o_l
        ac, bc = _rglru_coeffs(xr[0], wa[d], ba[d], wx[d], bx[d], lam[d])
        al, bl = _rglru_coeffs(xr[1], wa[d], ba[d], wx[d], bx[d], lam[d])
        h_c, h_l = _prefix_scan(_linear_scan, (ac, bc), (al, bl), d == 1)
        rg_c, rg_l = rg_c + h_c, rg_l + h_l

    def merge(hg, rg, p):
        hg = _rmsnorm(hg.reshape(hg.shape[:2] + (HG_WIDTH,)), onorm_g) * jax.nn.silu(p[4].astype(f32))
        rg = rg * jax.nn.gelu(p[6].astype(f32))
        return jnp.concatenate([hg, rg], axis=-1).astype(p[0].dtype) @ w_out

    o_lat = merge(hg_l, rg_l, pl)
    o_ctx = merge(hg_c, rg_c, pc) if with_ctx_out else None
    return o_lat, o_ctx


def _na_column_tables():
    nb = GRID_W // NA_QB
    c0 = np.arange(nb) * NA_QB
    band = np.clip(c0 - NA_KC // 2, 0, GRID_W - NA_CB)
    col_idx = band[:, None] + np.arange(NA_CB)
    qcol = c0[:, None] + np.arange(NA_QB)
    wstart = np.clip(qcol - NA_KC // 2, 0, GRID_W - NA_KC)
    kcol = col_idx[:, None, :]
    mask = (kcol >= wstart[..., None]) & (kcol < wstart[..., None] + NA_KC)
    off = np.clip(kcol - qcol[..., None] + NA_KC - 1, 0, 2 * NA_KC - 2)
    return col_idx, mask, off


def _na_mixer(u_ctx, u_lat, w_qkv, w_o, q_g, k_g, rpb, with_ctx_out):
    f32 = jnp.float32
    B, S, _ = u_lat.shape
    rows = S // GRID_W
    kr = min(NA_KR, rows)
    nb = GRID_W // NA_QB
    scale = NA_HEAD_DIM ** -0.5

    def qkv(u):
        q, k, v = jnp.split(u @ w_qkv, 3, axis=-1)
        shp = u.shape[:2] + (NA_HEADS, NA_HEAD_DIM)
        return (_rmsnorm(q.reshape(shp), q_g) * scale, _rmsnorm(k.reshape(shp), k_g), v.reshape(shp))

    qc, kc, vc = qkv(u_ctx)
    ql, kl, vl = qkv(u_lat)
    kc_h = kc.transpose(0, 2, 1, 3)
    vc_h = vc.transpose(0, 2, 1, 3)

    def to_grid(a):
        return a.reshape(B, rows, GRID_W, NA_HEADS, NA_HEAD_DIM).transpose(0, 3, 1, 2, 4)

    qg, kg, vg = to_grid(ql), to_grid(kl), to_grid(vl)
    col_idx, col_mask, col_off = _na_column_tables()
    bias = rpb.astype(f32)[:, :, col_off].transpose(0, 2, 3, 1, 4)
    bias = jnp.where(col_mask[:, :, None, :], bias, NEG_BIG)
    n_loc = kr * NA_CB

    def row_block(r):
        rs = jnp.clip(r - kr // 2, 0, rows - kr)
        q_r = lax.dynamic_index_in_dim(qg, r, axis=2, keepdims=False).reshape(
            B, NA_HEADS, nb, NA_QB, NA_HEAD_DIM)
        k_b = lax.dynamic_slice_in_dim(kg, rs, kr, axis=2)[:, :, :, col_idx]
        v_b = lax.dynamic_slice_in_dim(vg, rs, kr, axis=2)[:, :, :, col_idx]
        b_r = jnp.take(bias, rs + jnp.arange(kr) - r + (NA_KR - 1), axis=3)
        s_loc = jnp.einsum('bhnqd,bhrncd->bhnqrc', q_r, k_b).astype(f32) + b_r
        s_ctx = jnp.einsum('bhnqd,bhld->bhnql', q_r, kc_h).astype(f32)
        s = jnp.concatenate([s_loc.reshape(B, NA_HEADS, nb, NA_QB, n_loc), s_ctx], axis=-1)
        p = jax.nn.softmax(s, axis=-1).astype(vg.dtype)
        p_loc = p[..., :n_loc].reshape(B, NA_HEADS, nb, NA_QB, kr, NA_CB)
        o = (jnp.einsum('bhnqrc,bhrncd->bhnqd', p_loc, v_b)
             + jnp.einsum('bhnql,bhld->bhnqd', p[..., n_loc:], vc_h))
        return o.reshape(B, NA_HEADS, GRID_W, NA_HEAD_DIM)

    o = lax.map(row_block, jnp.arange(rows))
    o_lat = o.transpose(1, 0, 3, 2, 4).reshape(B, S, D_MODEL) @ w_o
    o_ctx = None
    if with_ctx_out:
        s = jnp.einsum('blhd,bmhd->bhlm', qc, kc).astype(f32)
        p = jax.nn.softmax(s, axis=-1).astype(vc.dtype)
        o_ctx = jnp.einsum('bhlm,bmhd->blhd', p, vc).reshape(u_ctx.shape) @ w_o
    return o_lat, o_ctx


def setup_inputs(seed: int = 0) -> dict:
    key = jax.random.key(seed)
    keys = iter(jax.random.split(key, 40))
    f32 = jnp.float32
    D = D_MODEL

    def nrm(shape, scale):
        return jax.random.normal(next(keys), shape, f32) * scale

    def gain(shape):
        return 1.0 + nrm(shape, 0.1)

    a0 = jax.random.uniform(next(keys), (N_EVEN, 2, RG_WIDTH), f32, 0.9, 0.999)
    p0 = a0 ** (1.0 / RG_C)
    return {
        "x": nrm((BATCH, SEQ, D), 1.0),
        "c": nrm((BATCH, D), 1.0),
        "ctx": nrm((BATCH, CTX_LEN, D), 1.0),
        "c_ctx": nrm((D,), 1.0),
        "w_mod": nrm((DEPTH, D, N_MOD * D), 0.5 * D ** -0.5),
        "b_mod": nrm((DEPTH, N_MOD * D), 0.05),
        "norm_mix_g": gain((DEPTH, D)),
        "norm_ffn_g": gain((DEPTH, D)),
        "ev_w_in": nrm((N_EVEN, D, EVEN_IN), D ** -0.5),
        "ev_w_out": nrm((N_EVEN, D, D), D ** -0.5),
        "hg_lb_logits": nrm((N_EVEN, 2, HG_WIDTH), 1.0),
        "hg_onorm_g": gain((N_EVEN, HG_WIDTH)),
        "rg_conv_w": nrm((N_EVEN, RG_CONV, RG_WIDTH), RG_CONV ** -0.5),
        "rg_conv_b": nrm((N_EVEN, RG_WIDTH), 0.1),
        "rg_wa": nrm((N_EVEN, 2, RG_BLOCKS, RG_BLOCK, RG_BLOCK), RG_BLOCK ** -0.5),
        "rg_ba": nrm((N_EVEN, 2, RG_WIDTH), 0.1),
        "rg_wx": nrm((N_EVEN, 2, RG_BLOCKS, RG_BLOCK, RG_BLOCK), RG_BLOCK ** -0.5),
        "rg_bx": nrm((N_EVEN, 2, RG_WIDTH), 0.1),
        "rg_lambda": jnp.log(p0) - jnp.log1p(-p0),
        "na_w_qkv": nrm((N_ODD, D, 3 * D), D ** -0.5),
        "na_w_o": nrm((N_ODD, D, D), D ** -0.5),
        "na_q_g": gain((N_ODD, NA_HEAD_DIM)),
        "na_k_g": gain((N_ODD, NA_HEAD_DIM)),
        "na_rpb": nrm((N_ODD, NA_HEADS, 2 * NA_KR - 1, 2 * NA_KC - 1), 0.5),
        "ffn_w1": nrm((N_EVEN, D, D_FF), D ** -0.5),
        "ffn_w3": nrm((N_EVEN, D, D_FF), D ** -0.5),
        "ffn_w2": nrm((N_EVEN, D_FF, D), D_FF ** -0.5),
        "moe_router": nrm((N_ODD, D, N_EXPERTS), D ** -0.5),
        "moe_w1": nrm((N_ODD, N_EXPERTS, D, D_FF_EXPERT), D ** -0.5),
        "moe_w3": nrm((N_ODD, N_EXPERTS, D, D_FF_EXPERT), D ** -0.5),
        "moe_w2": nrm((N_ODD, N_EXPERTS, D_FF_EXPERT, D), D_FF_EXPERT ** -0.5),
    }


def reference(x, c, ctx, c_ctx, w_mod, b_mod, norm_mix_g, norm_ffn_g,
              ev_w_in, ev_w_out, hg_lb_logits, hg_onorm_g, rg_conv_w, rg_conv_b,
              rg_wa, rg_ba, rg_wx, rg_bx, rg_lambda,
              na_w_qkv, na_w_o, na_q_g, na_k_g, na_rpb,
              ffn_w1, ffn_w3, ffn_w2, moe_router, moe_w1, moe_w3, moe_w2):
    n_ctx = ctx.shape[1]
    lb_p = jax.nn.softmax(hg_lb_logits.astype(jnp.float32), axis=0)
    lb_all = jnp.cumsum(lb_p, axis=0) - lb_p[0]
    h, g = x, ctx
    for layer in range(DEPTH):
        j = layer // 2
        last = layer == DEPTH - 1
        sh1, sc1, gt1, sh2, sc2, gt2 = [t[:, None, :] for t in _adaln(c, w_mod[layer], b_mod[layer])]
        csh1, csc1, cgt1, csh2, csc2, cgt2 = _adaln(c_ctx, w_mod[layer], b_mod[layer])
        u_lat = _modulate(h, norm_mix_g[layer], sh1, sc1)
        u_ctx = _modulate(g, norm_mix_g[layer], csh1, csc1)
        if layer % 2 == 0:
            o_lat, o_ctx = _even_mixer(u_ctx, u_lat, ev_w_in[j], ev_w_out[j], lb_all[j], hg_onorm_g[j],
                                       rg_conv_w[j], rg_conv_b[j], rg_wa[j], rg_ba[j],
                                       rg_wx[j], rg_bx[j], rg_lambda[j], not last)
        else:
            o_lat, o_ctx = _na_mixer(u_ctx, u_lat, na_w_qkv[j], na_w_o[j], na_q_g[j], na_k_g[j],
                                     na_rpb[j], not last)
        h = h + gt1 * o_lat
        u_lat = _modulate(h, norm_ffn_g[layer], sh2, sc2)
        if last:
            tokens = u_lat
        else:
            g = g + cgt1 * o_ctx
            tokens = jnp.concatenate([_modulate(g, norm_ffn_g[layer], csh2, csc2), u_lat], axis=1)
        if layer % 2 == 0:
            y = _swiglu(tokens, ffn_w1[j], ffn_w3[j], ffn_w2[j])
        else:
            y = _moe(tokens, moe_router[j], moe_w1[j], moe_w3[j], moe_w2[j])
        if last:
            h = h + gt2 * y
        else:
            g = g + cgt2 * y[:, :n_ctx]
            h = h + gt2 * y[:, n_ctx:]
    return h
```

```cpp
#include <hip/hip_runtime.h>
#include <cstdio>
#include <cstdint>

#define GAS __attribute__((address_space(1)))
#define LAS __attribute__((address_space(3)))
#define DI __device__ __forceinline__
typedef unsigned short bf16;
typedef short bf16x8 __attribute__((ext_vector_type(8)));
typedef short s16x4 __attribute__((ext_vector_type(4)));
typedef short v4i16_t __attribute__((ext_vector_type(4)));
typedef float f32x2 __attribute__((ext_vector_type(2)));
typedef float f32x4 __attribute__((ext_vector_type(4)));
typedef float f32x16 __attribute__((ext_vector_type(16)));
typedef unsigned u32x2 __attribute__((ext_vector_type(2)));
typedef unsigned u32x4 __attribute__((ext_vector_type(4)));
typedef __bf16 bf16x2_t __attribute__((ext_vector_type(2)));

#ifndef MK_SPLIT
#define MK_SPLIT 0
#endif

constexpr int DM = 1024, NBATCH = 8, SEQ = 2048, CTXL = 256, TB = SEQ + CTXL  , T = NBATCH * TB  ;
constexpr int HGW = 512, EVIN = 3584, DFF = 2816, NEXP = 8, NHEAD = 16;
constexpr int MAXSLOT = 38912;
constexpr float EPS = 1e-6f;

DI unsigned cvtpk(float lo, float hi) { f32x2 v = {lo, hi}; bf16x2_t b = __builtin_convertvector(v, bf16x2_t); return __builtin_bit_cast(unsigned, b); }
DI float bf2f(unsigned short b) { return __uint_as_float(((unsigned)b) << 16); }
DI float bflo(unsigned w) { return __uint_as_float(w << 16); }
DI float bfhi(unsigned w) { return __uint_as_float(w & 0xffff0000u); }
DI float sigmoid_(float x) { return __builtin_amdgcn_rcpf(1.f + __expf(-x)); }
DI float silu_(float x) { return x * sigmoid_(x); }
DI float logsigmoid_(float x) { return fminf(x, 0.f) - log1pf(__expf(-fabsf(x))); }
DI float gelu_tanh_(float x) { const float u = 0.7978845608028654f * (x + 0.044715f * x * x * x); const float t = 1.f - 2.f * __builtin_amdgcn_rcpf(1.f + __expf(2.f * u)); return 0.5f * x * (1.f + t); }
template <int CTRL, int RM> DI float dpp_mov(float v) { return __builtin_bit_cast(float, __builtin_amdgcn_update_dpp(0, __builtin_bit_cast(int, v), CTRL, RM, 0xf, false)); }
DI float wave_sum(float v) {
    v += dpp_mov<0xB1, 0xf>(v); v += dpp_mov<0x4E, 0xf>(v); v += dpp_mov<0x141, 0xf>(v); v += dpp_mov<0x140, 0xf>(v);
    v += dpp_mov<0x142, 0xa>(v); v += dpp_mov<0x143, 0xc>(v);
    return __builtin_bit_cast(float, __builtin_amdgcn_readlane(__builtin_bit_cast(int, v), 63));
}
constexpr int TIDTAB_OFF = 131072 + 1024;
DI int hw_wave_slot() { return (int)(__builtin_amdgcn_s_getreg(0x2804) & 63u); }
DI int opaque_tid() {
    const int wv = *(const volatile LAS int*)(size_t)(TIDTAB_OFF + 4 * hw_wave_slot());
    int lane; asm volatile("v_mbcnt_lo_u32_b32 %0, -1, 0\n\tv_mbcnt_hi_u32_b32 %0, -1, %0" : "=&v"(lane));
    return (__builtin_amdgcn_readfirstlane(wv) << 6) | lane; }
DI s16x4 vtr(const LAS unsigned char* p) { return __builtin_bit_cast(s16x4, __builtin_amdgcn_ds_read_tr16_b64_v4i16((LAS v4i16_t*)p)); }
DI bf16x8 cat8(s16x4 lo, s16x4 hi) { return __builtin_shufflevector(lo, hi, 0, 1, 2, 3, 4, 5, 6, 7); }
DI int crow(int reg, int h) { return (reg & 3) + 8 * (reg >> 2) + 4 * h; }
#define MFMA32(a, b, c) __builtin_amdgcn_mfma_f32_32x32x16_bf16((a), (b), (c), 0, 0, 0)
DI bf16x8 pack8(const f32x16& x, int s) {
    u32x4 p; p.x = cvtpk(x[8 * s], x[8 * s + 1]); p.y = cvtpk(x[8 * s + 2], x[8 * s + 3]); p.z = cvtpk(x[8 * s + 4], x[8 * s + 5]); p.w = cvtpk(x[8 * s + 6], x[8 * s + 7]);
    return __builtin_bit_cast(bf16x8, p);
}

namespace pg8 {
constexpr int BM = 256, BK = 64, HALF = 128, HTB = HALF * BK * 2, STAGE_BYTES = 8 * HTB, NXCD = 8, WGM = 8;
__host__ __device__ __forceinline__ int lds_byte(int r, int c) { const int st = (r >> 4) * 2 + (c >> 5), rr = r & 15, cc = c & 31, ob = rr * 64 + cc * 2; return st * 1024 + (ob ^ (((ob >> 9) & 1) << 5)); }
__host__ __device__ __forceinline__ void stage_rc(int b, int& R, int& C) { const int st = b / 1024, sb = b % 1024, swz = sb ^ (((sb >> 9) & 1) << 5); R = (st >> 1) * 16 + swz / 64; C = (st & 1) * 32 + (swz % 64) / 2; }
__host__ __device__ __forceinline__ int perm32(int rho) { const int n = rho >> 4, i = rho & 15; return 8 * (i >> 2) + 4 * n + (i & 3); }

struct Unit { int pm, pn, pb, ka, kb, part, tix; };
struct Gemm { const bf16* A; const bf16* Bt; int lda, K, kloop; };

struct GOrder {
    int nM, nN, nwg, G, c, mode, P, Kp, imax, F, tail, i0; bool chunk; const int* tile_e;
    DI void init(int nM_, int nN_, int G_, int c_, int mode_, const int* te) { nM = nM_; nN = nN_; nwg = nM * nN; G = G_; c = c_; mode = mode_; tile_e = te; P = 1; Kp = 0; imax = 1 << 30; F = 0; tail = 0; i0 = 0; chunk = false; }
    DI bool next(int i, Unit& u) const {
        if (mode == 4) { if (i > 0 || c < 0 || c >= 8 * nN * P) return false; const int un = c / P, p = c - un * P; u.pm = 9 * (un / nN); u.pn = un % nN; u.pb = u.pn; u.ka = p * Kp; u.kb = p * Kp; u.part = p; u.tix = 0; return true; }
        if (i >= imax) return false;
        long L = (long)(i + i0) * G + c; if (L >= nwg) return false;
        int part = 0, tix = 0;
        if (mode == 6) {
            if (i > 0 || c >= 2 * tail) return false;
            tix = c >> 1; part = c & 1; L = F + tix; }
        const int xcd = (int)L % NXCD, off = (int)L / NXCD;
        int idx, nMx, pm0;
        if (chunk) { idx = off; nMx = nM / NXCD; pm0 = xcd * nMx; }
        else { const int q = nwg / NXCD, r = nwg % NXCD; idx = (xcd < r ? xcd * (q + 1) : r * (q + 1) + (xcd - r) * q) + off; nMx = nM; pm0 = 0; }
        const int nig = WGM * nN, gid = idx / nig, fm = gid * WGM, gsz = (nMx - fm) < WGM ? (nMx - fm) : WGM, rem = idx - gid * nig;
        const int pn = rem / gsz, pm = pm0 + fm + (rem - pn * gsz);
        u.pm = pm; u.pn = pn; u.pb = pn; u.ka = 0; u.kb = 0; u.part = part; u.tix = tix;
        if (mode == 1) u.pm = pm + pm / 8 + 1;
        else if (mode == 2) u.pb = __builtin_amdgcn_readfirstlane(tile_e[pm]) * nN + pn;
        else if (mode == 6) { u.pb = __builtin_amdgcn_readfirstlane(tile_e[pm]) * nN + pn; u.ka = part * Kp; u.kb = part * Kp; }
        else if (mode == 3) u.ka = 256 * ((pn & 3) >> 1);
        return true;
    }
};

template <class Epi>
DI void gemm_phase(LAS unsigned char* lds, const Gemm g, const GOrder& S, const Epi& E) {
    const int tid = opaque_tid(), wid = __builtin_amdgcn_readfirstlane(tid >> 6), lane = tid & 63, wr = wid >> 2, wc = wid & 3, fr = lane & 15, fq = lane >> 4;
    int K = g.K, lda = g.lda, kloop = g.kloop; asm volatile("" : "+s"(K), "+s"(lda), "+s"(kloop));
    const int nt = kloop / BK;
    unsigned voffA[2], voffB[2];
#pragma unroll
    for (int i = 0; i < 2; ++i) { int R, C; stage_rc(tid * 16 + i * 8192, R, C); const int Rb = Epi::PERM ? ((R & ~31) + perm32(R & 31)) : R;
        voffA[i] = (unsigned)(R * lda + C) * 2u; voffB[i] = (unsigned)(Rb * K + C) * 2u; }
    const size_t kstep = (size_t)(BK * 2);
    const size_t hstepA = (size_t)HALF * lda * 2, hstepB = (size_t)HALF * K * 2;
    const size_t tstepA = 2 * hstepA, tstepB = 2 * hstepB;
    const unsigned ldsw = (unsigned)wid * 1024u;
    const int aoff = lds_byte(wr * 64 + fr, fq * 8), boff = lds_byte(wc * 32 + fr, fq * 8);
#define PG8_SA(b, h) (((b) * 2 + (h)) * HTB)
#define PG8_SB(b, h) ((4 + (b) * 2 + (h)) * HTB)
#define PG8_STAGE(bufoff, gbase, voff) do { _Pragma("unroll") for (int _i = 0; _i < 2; ++_i) \
        __builtin_amdgcn_global_load_lds((const unsigned*)((const char*)(gbase) + (voff)[_i]), (LAS unsigned*)(lds + (bufoff) + ldsw + _i * 8192), 16, 0, 0); } while (0)
#define PG8_LDA(dst, b, h) do { _Pragma("unroll") for (int m = 0; m < 4; ++m) _Pragma("unroll") for (int k = 0; k < 2; ++k) dst[m][k] = *(const LAS bf16x8*)(lds + PG8_SA(b, h) + aoff + m * 2048 + k * 1024); } while (0)
#define PG8_LDB(dst, b, h) do { _Pragma("unroll") for (int n = 0; n < 2; ++n) _Pragma("unroll") for (int k = 0; k < 2; ++k) dst[n][k] = *(const LAS bf16x8*)(lds + PG8_SB(b, h) + boff + n * 2048 + k * 1024); } while (0)
#define PG8_MMA(ai, bj, At, Bt) do { __builtin_amdgcn_s_setprio(1); _Pragma("unroll") for (int m = 0; m < 4; ++m) _Pragma("unroll") for (int n = 0; n < 2; ++n) _Pragma("unroll") for (int k = 0; k < 2; ++k) \
        acc[ai][bj][m][n] = __builtin_amdgcn_mfma_f32_16x16x32_bf16(Bt[n][k], At[m][k], acc[ai][bj][m][n], 0, 0, 0); __builtin_amdgcn_s_setprio(0); } while (0)
#define PG8_WAIT_V(n) asm volatile("s_waitcnt vmcnt(" #n ")" ::: "memory")
#define PG8_WAIT_L(n) asm volatile("s_waitcnt lgkmcnt(" #n ")" ::: "memory")
#define PG8_BAR __builtin_amdgcn_s_barrier()
#define PG8_SCHED __builtin_amdgcn_sched_barrier(0)
    Unit cur, nxt; int ui = 0;
    if (!S.next(0, cur)) return;
    f32x4 acc[2][2][4][2];
#pragma unroll
    for (int a = 0; a < 2; ++a)
#pragma unroll
        for (int b = 0; b < 2; ++b)
#pragma unroll
            for (int m = 0; m < 4; ++m)
#pragma unroll
                for (int n = 0; n < 2; ++n) acc[a][b][m][n] = (f32x4){0.f, 0.f, 0.f, 0.f};
    bf16x8 At[4][2], B0[2][2], B1[2][2];
    const char* cA = (const char*)g.A + (size_t)cur.pm * tstepA + (size_t)cur.ka * 2; const char* cB = (const char*)g.Bt + (size_t)cur.pb * tstepB + (size_t)cur.kb * 2;
    PG8_STAGE(PG8_SB(0, 0), cB, voffB); PG8_STAGE(PG8_SB(0, 1), cB + hstepB, voffB); PG8_STAGE(PG8_SA(0, 0), cA, voffA); PG8_STAGE(PG8_SA(0, 1), cA + hstepA, voffA);
    if (wr == 1) PG8_BAR;
    PG8_WAIT_V(2); PG8_BAR;
    PG8_STAGE(PG8_SB(1, 0), cB + kstep, voffB); PG8_STAGE(PG8_SA(1, 0), cA + kstep, voffA); PG8_STAGE(PG8_SB(1, 1), cB + hstepB + kstep, voffB);
    PG8_WAIT_V(6); PG8_BAR;
    for (;;) {
        const bool has_next = S.next(ui + 1, nxt);
        const char* nA = has_next ? (const char*)g.A + (size_t)nxt.pm * tstepA + (size_t)nxt.ka * 2 : cA; const char* nB = has_next ? (const char*)g.Bt + (size_t)nxt.pb * tstepB + (size_t)nxt.kb * 2 : cB;
        for (int t = 0; t < nt; t += 2) {
            const bool last = (t == nt - 2);
            const char* a1 = cA + (size_t)(t + 1) * kstep;
            const char* a2 = last ? nA : cA + (size_t)(t + 2) * kstep; const char* b2 = last ? nB : cB + (size_t)(t + 2) * kstep;
            const char* a3 = a2 + kstep; const char* b3 = b2 + kstep;
            PG8_LDB(B0, 0, 0); PG8_LDB(B1, 0, 1); PG8_SCHED; PG8_LDA(At, 0, 0); PG8_STAGE(PG8_SA(1, 1), a1 + hstepA, voffA);
            PG8_WAIT_V(8); PG8_WAIT_L(0); PG8_BAR; PG8_MMA(0, 0, At, B0); PG8_MMA(0, 1, At, B1); PG8_BAR; PG8_SCHED;
            PG8_LDA(At, 0, 1); PG8_STAGE(PG8_SB(0, 0), b2, voffB); PG8_STAGE(PG8_SB(0, 1), b2 + hstepB, voffB); PG8_STAGE(PG8_SA(0, 0), a2, voffA);
            PG8_WAIT_V(8); PG8_WAIT_L(0); PG8_BAR; PG8_MMA(1, 0, At, B0); PG8_MMA(1, 1, At, B1); PG8_BAR; PG8_SCHED;
            PG8_LDB(B0, 1, 0); PG8_LDB(B1, 1, 1); PG8_SCHED; PG8_LDA(At, 1, 0); PG8_STAGE(PG8_SA(0, 1), a2 + hstepA, voffA);
            PG8_WAIT_V(8); PG8_WAIT_L(0); PG8_BAR; PG8_MMA(0, 0, At, B0); PG8_MMA(0, 1, At, B1); PG8_BAR; PG8_SCHED;
            PG8_LDA(At, 1, 1); PG8_STAGE(PG8_SB(1, 0), b3, voffB); PG8_STAGE(PG8_SB(1, 1), b3 + hstepB, voffB); PG8_STAGE(PG8_SA(1, 0), a3, voffA);
            PG8_WAIT_V(8); PG8_WAIT_L(0); PG8_BAR; PG8_MMA(1, 0, At, B0); PG8_MMA(1, 1, At, B1); PG8_BAR; PG8_SCHED;
        }
        if (wr == 0) PG8_BAR;
        E(acc, cur, wr, wc, fr, fq);
        if (!has_next) break;
#pragma unroll
        for (int a = 0; a < 2; ++a)
#pragma unroll
            for (int b = 0; b < 2; ++b)
#pragma unroll
                for (int m = 0; m < 4; ++m)
#pragma unroll
                    for (int n = 0; n < 2; ++n) acc[a][b][m][n] = (f32x4){0.f, 0.f, 0.f, 0.f};
        cur = nxt; cA = nA; cB = nB; ++ui;
        if (wr == 1) PG8_BAR;
    }
    PG8_WAIT_V(0);
    PG8_BAR;
#undef PG8_SA
#undef PG8_SB
#undef PG8_STAGE
#undef PG8_LDA
#undef PG8_LDB
#undef PG8_MMA
#undef PG8_WAIT_V
#undef PG8_WAIT_L
#undef PG8_BAR
#undef PG8_SCHED
}
}
using pg8::Unit;
using pg8::Gemm;
using pg8::GOrder;

#define XB_TMO      128
#define XB_XCNT(j)  (256  + 64 * (j))
#define XB_XSUB(j)  (1280 + 64 * (j))
#define XB_XGEN(j)  (2304 + 64 * (j))
#define XB_TOP      3328
#define XB_TOPGEN   3392
#define XCD_BAR_WORDS 3456
#define XB_SPIN_CAP (1u << 18)
__device__ __forceinline__ unsigned xb_ld(unsigned* p)              { return __hip_atomic_load(p, __ATOMIC_RELAXED, __HIP_MEMORY_SCOPE_AGENT); }
__device__ __forceinline__ unsigned xb_add(unsigned* p, unsigned v) { return __hip_atomic_fetch_add(p, v, __ATOMIC_RELAXED, __HIP_MEMORY_SCOPE_AGENT); }
__device__ __forceinline__ unsigned xb_xcc_id() { return (unsigned)__builtin_amdgcn_s_getreg((3 << 11) | 20) & 0xFu; }
#define XB_SPIN(cond, bar) do { unsigned _sp = 0; while (cond) { __builtin_amdgcn_s_sleep(1); \
    if ((++_sp & 255u) == 0u) { if (xb_ld(&(bar)[XB_TMO])) break; if (_sp > XB_SPIN_CAP) { atomicAdd(&(bar)[XB_TMO], 1u); break; } } } } while (0)
struct XcdBarrier { unsigned* bar; unsigned x; volatile LAS unsigned* st; };
__device__ __forceinline__ XcdBarrier xcd_barrier_post(unsigned* bar, volatile LAS unsigned* st) {
    XcdBarrier b; b.bar = bar; b.x = xb_xcc_id(); b.st = st;
    if (opaque_tid() == 0) (void)xb_add(&bar[XB_XCNT(b.x)], 1u);
    return b;
}
__device__ __forceinline__ void xcd_barrier_complete(unsigned* bar, unsigned x, unsigned& nloc, unsigned& nx) {
    const unsigned G = gridDim.x * gridDim.y * gridDim.z;
    unsigned sum, cnt, mine, sp = 0u;
    for (;;) {
        sum = 0u; cnt = 0u; mine = 0u;
#pragma unroll
        for (unsigned j = 0; j < 16; ++j) { const unsigned c = xb_ld(&bar[XB_XCNT(j)]); sum += c; cnt += (c > 0u) ? 1u : 0u; mine = (j == x) ? c : mine; }
        if (sum == G) break;
        __builtin_amdgcn_s_sleep(1);
        if ((++sp & 255u) == 0u) { if (xb_ld(&bar[XB_TMO])) break; if (sp > XB_SPIN_CAP) { atomicAdd(&bar[XB_TMO], 1u); break; } }
    }
    nloc = mine > 0u ? mine : 1u; nx = cnt > 0u ? cnt : 1u;
}
__device__ __forceinline__ void xcd_barrier(const XcdBarrier& b) {
    asm volatile("s_waitcnt vmcnt(0)" ::: "memory");
    __syncthreads();
    if (opaque_tid() == 0) {
        unsigned* bar = b.bar;
        __builtin_amdgcn_s_waitcnt(0);
        unsigned nloc = b.st[0], nx = b.st[1];
        if (nloc == 0u) { xcd_barrier_complete(bar, b.x, nloc, nx); b.st[0] = nloc; b.st[1] = nx; }
        const unsigned old = xb_add(&bar[XB_XSUB(b.x)], 1u);
        const unsigned gen = old / nloc;
        if (old + 1u == (gen + 1u) * nloc) {
            __builtin_amdgcn_fence(__ATOMIC_RELEASE, "agent");
            asm volatile("s_waitcnt vmcnt(0)" ::: "memory");
            const unsigned og = xb_add(&bar[XB_TOP], 1u);
            const unsigned tg = og / nx;
            if (og + 1u == (tg + 1u) * nx) xb_add(&bar[XB_TOPGEN], 1u);
            else XB_SPIN(xb_ld(&bar[XB_TOPGEN]) == tg, bar);
            __builtin_amdgcn_fence(__ATOMIC_ACQUIRE, "agent");
            xb_add(&bar[XB_XGEN(b.x)], 1u);
            asm volatile("s_waitcnt vmcnt(0)" ::: "memory");
        } else {
            XB_SPIN(xb_ld(&bar[XB_XGEN(b.x)]) == gen, bar);
            __builtin_amdgcn_fence(__ATOMIC_ACQUIRE, "agent");
            asm volatile("s_waitcnt vmcnt(0)" ::: "memory");
        }
    }
    __syncthreads();
}

__device__ __forceinline__ void sub_barrier(unsigned* cnt, unsigned target) {
    asm volatile("s_waitcnt vmcnt(0)" ::: "memory");
    __syncthreads();
    if (opaque_tid() == 0) {
        __builtin_amdgcn_fence(__ATOMIC_RELEASE, "agent");
        asm volatile("s_waitcnt vmcnt(0)" ::: "memory");
        (void)xb_add(cnt, 1u);
        unsigned sp = 0u;
        while (xb_ld(cnt) < target) { __builtin_amdgcn_s_sleep(1); if (++sp > (1u << 22)) break; }
        __builtin_amdgcn_fence(__ATOMIC_ACQUIRE, "agent");
        asm volatile("s_waitcnt vmcnt(0)" ::: "memory");
    }
    __syncthreads();
}

__device__ __forceinline__ void tail_signal(unsigned* cnt) {
    asm volatile("s_waitcnt vmcnt(0)" ::: "memory");
    __syncthreads();
    if (opaque_tid() == 0) { __builtin_amdgcn_fence(__ATOMIC_RELEASE, "agent"); asm volatile("s_waitcnt vmcnt(0)" ::: "memory"); (void)xb_add(cnt, 1u); }
}
__device__ __forceinline__ void tail_wait(unsigned* cnt, unsigned target) {
    __syncthreads();
    if (opaque_tid() == 0) {
        unsigned sp = 0u;
        while (xb_ld(cnt) < target) { __builtin_amdgcn_s_sleep(1); if (++sp > (1u << 22)) break; }
        __builtin_amdgcn_fence(__ATOMIC_ACQUIRE, "agent");
        asm volatile("s_waitcnt vmcnt(0)" ::: "memory");
    }
    __syncthreads();
}

constexpr size_t MiB = 1u << 20;
constexpr size_t WS_CTL = 0, CTL_ZERO_BYTES = 1 * MiB;
constexpr int CW_BAR = 4096;
constexpr int CW_TILE = 65536;
constexpr size_t WS_MOD = 1 * MiB;
constexpr size_t WS_LBT = 2 * MiB;
constexpr size_t WS_WG = 3 * MiB;
constexpr size_t WS_TOPE = 5 * MiB, WS_TOPW = WS_TOPE + 128 * 1024, WS_SLOT = WS_TOPW + 256 * 1024, WS_WCNT = WS_SLOT + 256 * 1024;
constexpr size_t WS_WIN = 8 * MiB, WS_WOUT = 22 * MiB, WS_W13 = 26 * MiB, WS_W2 = 48 * MiB, WS_WQKV = 59 * MiB, WS_WO = 71 * MiB, WS_MW13 = 75 * MiB, WS_MW2 = 163 * MiB;
constexpr size_t WS_R = 207 * MiB, WS_U = 279 * MiB, WS_AR = 315 * MiB, WS_PART = (315 + 437) * MiB, WS_D = WS_PART + 24 * MiB, WS_END = WS_D + 36 * MiB;
constexpr size_t AR_QH = 0, AR_KKF = 18 * MiB, AR_KKB = 36 * MiB, AR_VV = 54 * MiB, AR_GS = 72 * MiB, AR_YG = 90 * MiB, AR_LFF = 108 * MiB, AR_LFB = 144 * MiB, AR_XR = 180 * MiB,
                 AR_XC = 216 * MiB, AR_LAF = 234 * MiB, AR_LAB = 252 * MiB, AR_BBF = 270 * MiB, AR_BBB = 288 * MiB, AR_OF = 306 * MiB, AR_OB = 324 * MiB, AR_HF = 342 * MiB, AR_HB = 360 * MiB,
                 AR_MIX = 378 * MiB, AR_HID = 0;
constexpr size_t AR_QB = 0, AR_KB = 36 * MiB, AR_VB = 72 * MiB, AR_AO = 108 * MiB, AR_UG = 0, AR_HM = 76 * MiB, AR_Y32 = 285 * MiB;
static_assert((size_t)MAXSLOT * 1024 * 2 <= 76 * MiB && (size_t)MAXSLOT * DFF * 2 <= 209 * MiB && (size_t)MAXSLOT * 1024 * 4 <= 152 * MiB, "arena");
static_assert((size_t)T * DFF * 2 <= 108 * MiB, "HID");

constexpr int RING_BYTES = 131072, MISC_OFF = RING_BYTES + 320, LDS_BYTES = 147456;

struct EpiResid {
    static constexpr bool PERM = true;
    bf16* Dd; const float* gate;
    DI void operator()(const f32x4 (&acc)[2][2][4][2], const Unit& u, int wr, int wc, int fr, int fq) const {
        const int b = u.pm / 9, mrow = (u.pm - b * 9 == 0) ? 8 : b;
        const int row0 = u.pm * 256 + wr * 64 + fr, col0 = u.pn * 256 + wc * 32 + 8 * fq;
        f32x4 gv[2][2];
#pragma unroll
        for (int bj = 0; bj < 2; ++bj)
#pragma unroll
            for (int n = 0; n < 2; ++n) gv[bj][n] = *(const f32x4*)(gate + (size_t)mrow * 6144 + col0 + bj * 128 + n * 4);
#pragma unroll
        for (int ai = 0; ai < 2; ++ai)
#pragma unroll
            for (int m = 0; m < 4; ++m)
#pragma unroll
                for (int bj = 0; bj < 2; ++bj) { const f32x4 a0 = gv[bj][0] * acc[ai][bj][m][0], a1 = gv[bj][1] * acc[ai][bj][m][1];
                    u32x4 w; w.x = cvtpk(a0[0], a0[1]); w.y = cvtpk(a0[2], a0[3]); w.z = cvtpk(a1[0], a1[1]); w.w = cvtpk(a1[2], a1[3]);
                    *(u32x4*)(Dd + (size_t)(row0 + ai * 128 + m * 16) * DM + col0 + bj * 128) = w; }
    }
};
struct EpiResidPart {
    static constexpr bool PERM = true;
    bf16* Dd; const float* gate; float* part;
    DI void operator()(const f32x4 (&acc)[2][2][4][2], const Unit& u, int wr, int wc, int fr, int fq) const {
        const int b = u.pm / 9;
        const int row0 = wr * 64 + fr, col0 = u.pn * 256 + wc * 32 + 8 * fq;
#pragma unroll
        for (int bj = 0; bj < 2; ++bj) {
            const f32x4 g0 = *(const f32x4*)(gate + (size_t)8 * 6144 + col0 + bj * 128), g1 = *(const f32x4*)(gate + (size_t)8 * 6144 + col0 + bj * 128 + 4);
            if (u.part == 0) {
#pragma unroll
                for (int ai = 0; ai < 2; ++ai)
#pragma unroll
                    for (int m = 0; m < 4; ++m) { const f32x4 a0 = g0 * acc[ai][bj][m][0], a1 = g1 * acc[ai][bj][m][1];
                        u32x4 w; w.x = cvtpk(a0[0], a0[1]); w.y = cvtpk(a0[2], a0[3]); w.z = cvtpk(a1[0], a1[1]); w.w = cvtpk(a1[2], a1[3]);
                        *(u32x4*)(Dd + (size_t)(u.pm * 256 + row0 + ai * 128 + m * 16) * DM + col0 + bj * 128) = w; }
            } else {
                float* base = part + (size_t)(u.part - 1) * 2048 * DM + (size_t)(b * 256 + row0) * DM + col0 + bj * 128;
#pragma unroll
                for (int ai = 0; ai < 2; ++ai)
#pragma unroll
                    for (int m = 0; m < 4; ++m) { float* rowp = base + (size_t)(ai * 128 + m * 16) * DM;
                        *(f32x4*)rowp = g0 * acc[ai][bj][m][0]; *(f32x4*)(rowp + 4) = g1 * acc[ai][bj][m][1]; }
            }
        }
    }
};
struct EpiF32 {
    static constexpr bool PERM = false;
    float* C; int ldc;
    DI void operator()(const f32x4 (&acc)[2][2][4][2], const Unit& u, int wr, int wc, int fr, int fq) const {
        const int row0 = u.pm * 256 + wr * 64 + fr, col0 = u.pn * 256 + wc * 32 + 4 * fq;
#pragma unroll
        for (int ai = 0; ai < 2; ++ai)
#pragma unroll
            for (int m = 0; m < 4; ++m) { float* rowp = C + (size_t)(row0 + ai * 128 + m * 16) * ldc + col0;
#pragma unroll
                for (int bj = 0; bj < 2; ++bj)
#pragma unroll
                    for (int n = 0; n < 2; ++n) *(f32x4*)(rowp + bj * 128 + n * 16) = acc[ai][bj][m][n]; }
    }
};
struct EpiBf16 {
    static constexpr bool PERM = true;
    bf16* C; int ldc;
    DI void operator()(const f32x4 (&acc)[2][2][4][2], const Unit& u, int wr, int wc, int fr, int fq) const {
        const int row0 = u.pm * 256 + wr * 64 + fr, col0 = u.pn * 256 + wc * 32 + 8 * fq;
#pragma unroll
        for (int ai = 0; ai < 2; ++ai)
#pragma unroll
            for (int m = 0; m < 4; ++m)
#pragma unroll
                for (int bj = 0; bj < 2; ++bj) { const f32x4 a0 = acc[ai][bj][m][0], a1 = acc[ai][bj][m][1];
                    u32x4 w; w.x = cvtpk(a0[0], a0[1]); w.y = cvtpk(a0[2], a0[3]); w.z = cvtpk(a1[0], a1[1]); w.w = cvtpk(a1[2], a1[3]);
                    *(u32x4*)(C + (size_t)(row0 + ai * 128 + m * 16) * ldc + col0 + bj * 128) = w; }
    }
};
constexpr int CW_YF = 72064;
struct EpiMoeTail {
    static constexpr bool PERM = true;
    bf16* C; bf16* Y2; unsigned* flag;
    DI void operator()(const f32x4 (&acc)[2][2][4][2], const Unit& u, int wr, int wc, int fr, int fq) const {
        const int row0 = wr * 64 + fr, col0 = wc * 32 + 8 * fq;
        bf16* base = u.part == 0 ? C + (size_t)(u.pm * 256) * DM + u.pn * 256 : Y2 + (size_t)u.tix * 65536;
        const int ld = u.part == 0 ? DM : 256;
#pragma unroll
        for (int ai = 0; ai < 2; ++ai)
#pragma unroll
            for (int m = 0; m < 4; ++m)
#pragma unroll
                for (int bj = 0; bj < 2; ++bj) { const f32x4 a0 = acc[ai][bj][m][0], a1 = acc[ai][bj][m][1];
                    u32x4 w; w.x = cvtpk(a0[0], a0[1]); w.y = cvtpk(a0[2], a0[3]); w.z = cvtpk(a1[0], a1[1]); w.w = cvtpk(a1[2], a1[3]);
                    *(u32x4*)(base + (size_t)(row0 + ai * 128 + m * 16) * ld + col0 + bj * 128) = w; }
        if (u.part == 1 && wr == 0 && wc == 0 && fr == 0 && fq == 0) { const unsigned fv = (unsigned)__builtin_amdgcn_readfirstlane(u.tix) + 1u; __hip_atomic_store(flag + u.pm * 4 + u.pn, fv, __ATOMIC_RELAXED, __HIP_MEMORY_SCOPE_AGENT); }
    }
};
struct EpiSwiglu {
    static constexpr bool PERM = true;
    bf16* H; int ldc;
    DI void operator()(const f32x4 (&acc)[2][2][4][2], const Unit& u, int wr, int wc, int fr, int fq) const {
        const int row0 = u.pm * 256 + wr * 64 + fr, col0 = u.pn * 128 + wc * 32 + 8 * fq;
#pragma unroll
        for (int ai = 0; ai < 2; ++ai)
#pragma unroll
            for (int m = 0; m < 4; ++m) {
                const f32x4 a0 = acc[ai][0][m][0], a1 = acc[ai][0][m][1], g0 = acc[ai][1][m][0], g1 = acc[ai][1][m][1];
                u32x4 w;
                w.x = cvtpk(silu_(a0[0]) * g0[0], silu_(a0[1]) * g0[1]); w.y = cvtpk(silu_(a0[2]) * g0[2], silu_(a0[3]) * g0[3]);
                w.z = cvtpk(silu_(a1[0]) * g1[0], silu_(a1[1]) * g1[1]); w.w = cvtpk(silu_(a1[2]) * g1[2], silu_(a1[3]) * g1[3]);
                *(u32x4*)(H + (size_t)(row0 + ai * 128 + m * 16) * ldc + col0) = w; }
    }
};
struct EpiEvenIn {
    static constexpr bool PERM = true;
    unsigned char* ar; const float* lbt;
    DI void operator()(const f32x4 (&acc)[2][2][4][2], const Unit& u, int wr, int wc, int fr, int fq) const {
        const int sidx = u.pn >> 1;
        const int row0 = u.pm * 256 + wr * 64 + fr, cs0 = (u.pn & 1) * 256 + wc * 32 + 8 * fq;
        if (sidx == 1 || sidx == 2) {
            const int d = sidx - 1;
            bf16* KK = (bf16*)(ar + (d ? AR_KKB : AR_KKF)); bf16* LF = (bf16*)(ar + (d ? AR_LFB : AR_LFF));
#pragma unroll
            for (int bj = 0; bj < 2; ++bj) {
                const int cs = cs0 + bj * 128;
#pragma unroll
                for (int n = 0; n < 2; ++n) {
                    const f32x4 oml = *(const f32x4*)(lbt + (d * 3 + 0) * 512 + cs + 4 * n), lbm = *(const f32x4*)(lbt + (d * 3 + 1) * 512 + cs + 4 * n);
#pragma unroll
                    for (int ai = 0; ai < 2; ++ai)
#pragma unroll
                        for (int m = 0; m < 4; ++m) {
                            const size_t o = (size_t)(row0 + ai * 128 + m * 16) * HGW + cs + 4 * n;
                            float kk[4]; f32x4 lf;
#pragma unroll
                            for (int e = 0; e < 4; ++e) { const float z = fminf(fmaxf(acc[ai][bj][m][n][e], -80.f), 80.f);
                                const float ez = __expf(-z), sg = __builtin_amdgcn_rcpf(1.f + ez);
                                kk[e] = oml[e] * (ez * sg);
                                lf[e] = __logf(lbm[e] + oml[e] * sg); }
                            u32x2 w; w.x = cvtpk(kk[0], kk[1]); w.y = cvtpk(kk[2], kk[3]);
                            *(u32x2*)(KK + o) = w;
                            w.x = cvtpk(lf[0], lf[1]); w.y = cvtpk(lf[2], lf[3]);
                            *(u32x2*)(LF + o) = w; }
                }
            }
        } else {
            bf16* O = (bf16*)(ar + (sidx == 0 ? AR_QH : sidx == 3 ? AR_VV : sidx == 4 ? AR_GS : sidx == 5 ? AR_XR : AR_YG));
#define EVEN_STORE(FN) do { _Pragma("unroll") for (int ai = 0; ai < 2; ++ai) _Pragma("unroll") for (int m = 0; m < 4; ++m) _Pragma("unroll") for (int bj = 0; bj < 2; ++bj) { \
                const size_t o = (size_t)(row0 + ai * 128 + m * 16) * HGW + cs0 + bj * 128; float v[8]; \
                _Pragma("unroll") for (int e = 0; e < 8; ++e) { const float z = acc[ai][bj][m][e >> 2][e & 3]; v[e] = FN; } \
                u32x4 w; w.x = cvtpk(v[0], v[1]); w.y = cvtpk(v[2], v[3]); w.z = cvtpk(v[4], v[5]); w.w = cvtpk(v[6], v[7]); \
                *(u32x4*)(O + o) = w; } } while (0)
            if (sidx == 3 || sidx == 5) EVEN_STORE(z); else if (sidx == 6) EVEN_STORE(gelu_tanh_(z)); else EVEN_STORE(silu_(z));
#undef EVEN_STORE
        }
    }
};
struct EpiGate {
    static constexpr bool PERM = true;
    unsigned char* ar; const float* ba; const float* bx;
    DI void operator()(const f32x4 (&acc)[2][2][4][2], const Unit& u, int wr, int wc, int fr, int fq) const {
        const int d = u.pn >> 2, cg = u.pn & 3, ch0 = 128 * cg + 32 * wc + 8 * fq;
        const int row0 = u.pm * 256 + wr * 64 + fr;
        bf16* RA = (bf16*)(ar + (d ? AR_LAB : AR_LAF)); bf16* IX = (bf16*)(ar + (d ? AR_BBB : AR_BBF));
        const f32x4 ba0 = *(const f32x4*)(ba + d * 512 + ch0), ba1 = *(const f32x4*)(ba + d * 512 + ch0 + 4), bx0 = *(const f32x4*)(bx + d * 512 + ch0), bx1 = *(const f32x4*)(bx + d * 512 + ch0 + 4);
#pragma unroll
        for (int ai = 0; ai < 2; ++ai)
#pragma unroll
            for (int m = 0; m < 4; ++m) {
                const size_t o = (size_t)(row0 + ai * 128 + m * 16) * HGW + ch0;
                const f32x4 r0 = acc[ai][0][m][0] + ba0, r1 = acc[ai][0][m][1] + ba1, i0 = acc[ai][1][m][0] + bx0, i1 = acc[ai][1][m][1] + bx1;
                u32x4 w; w.x = cvtpk(r0[0], r0[1]); w.y = cvtpk(r0[2], r0[3]); w.z = cvtpk(r1[0], r1[1]); w.w = cvtpk(r1[2], r1[3]);
                *(u32x4*)(RA + o) = w;
                w.x = cvtpk(i0[0], i0[1]); w.y = cvtpk(i0[2], i0[3]); w.z = cvtpk(i1[0], i1[1]); w.w = cvtpk(i1[2], i1[3]);
                *(u32x4*)(IX + o) = w; }
    }
};
struct EpiQKV {
    static constexpr bool PERM = true;
    unsigned char* ar; const float* qg; const float* kg;
    DI void operator()(const f32x4 (&acc)[2][2][4][2], const Unit& u, int wr, int wc, int fr, int fq) const {
        const int sec = u.pn >> 2, head = (u.pn & 3) * 4 + wc;
        const int row0 = u.pm * 256 + wr * 64 + fr;
        bf16* O = (bf16*)(ar + (sec == 0 ? AR_QB : sec == 1 ? AR_KB : AR_VB));
        float gv[2][8];
#pragma unroll
        for (int bj = 0; bj < 2; ++bj)
#pragma unroll
            for (int e = 0; e < 8; ++e) gv[bj][e] = sec == 0 ? qg[32 * bj + 8 * fq + e] * (0.125f * 1.4426950408889634f) : (sec == 1 ? kg[32 * bj + 8 * fq + e] : 1.f);
#pragma unroll
        for (int ai = 0; ai < 2; ++ai)
#pragma unroll
            for (int m = 0; m < 4; ++m) {
                float ss = 0.f;
#pragma unroll
                for (int bj = 0; bj < 2; ++bj)
#pragma unroll
                    for (int n = 0; n < 2; ++n) { const f32x4 x = acc[ai][bj][m][n]; ss += (x[0] * x[0] + x[1] * x[1]) + (x[2] * x[2] + x[3] * x[3]); }
                ss += __shfl_xor(ss, 16); ss += __shfl_xor(ss, 32);
                const float rstd = sec < 2 ? rsqrtf(ss * (1.f / 64.f) + EPS) : 1.f;
#pragma unroll
                for (int bj = 0; bj < 2; ++bj) {
                    float v[8];
#pragma unroll
                    for (int e = 0; e < 8; ++e) v[e] = acc[ai][bj][m][e >> 2][e & 3] * rstd * gv[bj][e];
                    u32x4 w; w.x = cvtpk(v[0], v[1]); w.y = cvtpk(v[2], v[3]); w.z = cvtpk(v[4], v[5]); w.w = cvtpk(v[6], v[7]);
                    *(u32x4*)(O + (size_t)(row0 + ai * 128 + m * 16) * DM + head * 64 + 32 * bj + 8 * fq) = w; }
            }
    }
};

#define LDS_WAIT() asm volatile("s_waitcnt lgkmcnt(0)" ::: "memory")
DI unsigned short bfbits(float x) { return (unsigned short)(cvtpk(x, 0.f) & 0xffffu); }

template <int MAP> DI int dst_row(int n) {
    if (MAP == 0) return n;
    if (MAP == 1) { const int nl = n & 255; return (n & ~255) + 128 * ((nl >> 5) & 1) + 32 * (nl >> 6) + (nl & 31); }
    if (MAP == 2) return (n >> 7) * 256 + (n & 127);
    return (n >> 7) * 256 + 128 + (n & 127);
}
template <int MAP> DI void transpose_item(const float* W, int K, int N, bf16* WT, LAS float* scr_, int item, int lane) {
    LAS unsigned char* scr = (LAS unsigned char*)scr_;
    const int nblk = N / 64, kb = item / nblk, nb = item - kb * nblk, k0 = 64 * kb, n0 = 64 * nb;
    const float* src = W + (size_t)k0 * N + n0 + lane;
    float v[64];
#pragma unroll
    for (int i = 0; i < 64; ++i) v[i] = src[(size_t)i * N];
#pragma unroll
    for (int i = 0; i < 32; ++i) *(LAS unsigned*)(scr + lane * 136 + 4 * i) = cvtpk(v[2 * i], v[2 * i + 1]);
    LDS_WAIT(); asm volatile("" ::: "memory");
    const int c = lane & 7;
#pragma unroll
    for (int j = 0; j < 8; ++j) { const int n = (lane >> 3) + 8 * j;
        const u32x2 lo = *(const LAS u32x2*)(scr + n * 136 + 16 * c), hi = *(const LAS u32x2*)(scr + n * 136 + 16 * c + 8);
        u32x4 o; o.x = lo.x; o.y = lo.y; o.z = hi.x; o.w = hi.y;
        *(u32x4*)(WT + (size_t)dst_row<MAP>(n0 + n) * K + k0 + 8 * c) = o; }
    LDS_WAIT(); asm volatile("" ::: "memory");
}

struct Ptrs {
    const float* in[31]; float* out; unsigned char* ws; int ph_lo, ph_hi;
};
enum { I_X = 0, I_C, I_CTX, I_CCTX, I_WMOD, I_BMOD, I_NMIXG, I_NFFNG, I_EVWIN, I_EVWOUT, I_LBLOG, I_ONORMG, I_CONVW, I_CONVB, I_WA, I_BA, I_WX, I_BX, I_LAM,
       I_WQKV, I_WO, I_QG, I_KG, I_RPB, I_FW1, I_FW3, I_FW2, I_ROUTER, I_MW1, I_MW3, I_MW2 };

constexpr int DW_IN = 16 * (EVIN / 64), DW_SQ = 16 * 16, DW_F1 = 16 * (DFF / 64), DW_F2 = (DFF / 64) * 16, DW_QKV = 16 * 48;
constexpr int DW_PER_J = DW_IN + DW_SQ + 2 * DW_F1 + DW_F2 + DW_QKV + DW_SQ;
DI void dense_weight_item(const Ptrs& P, LAS float* scr, int j, int r, int lane) {
    unsigned char* ws = P.ws;
    if (r < DW_IN) { transpose_item<0>(P.in[I_EVWIN] + (size_t)j * DM * EVIN, DM, EVIN, (bf16*)(ws + WS_WIN) + (size_t)j * EVIN * DM, scr, r, lane); return; } r -= DW_IN;
    if (r < DW_SQ) { transpose_item<0>(P.in[I_EVWOUT] + (size_t)j * DM * DM, DM, DM, (bf16*)(ws + WS_WOUT) + (size_t)j * DM * DM, scr, r, lane); return; } r -= DW_SQ;
    if (r < DW_F1) { transpose_item<2>(P.in[I_FW1] + (size_t)j * DM * DFF, DM, DFF, (bf16*)(ws + WS_W13) + (size_t)j * 2 * DFF * DM, scr, r, lane); return; } r -= DW_F1;
    if (r < DW_F1) { transpose_item<3>(P.in[I_FW3] + (size_t)j * DM * DFF, DM, DFF, (bf16*)(ws + WS_W13) + (size_t)j * 2 * DFF * DM, scr, r, lane); return; } r -= DW_F1;
    if (r < DW_F2) { transpose_item<0>(P.in[I_FW2] + (size_t)j * DFF * DM, DFF, DM, (bf16*)(ws + WS_W2) + (size_t)j * DM * DFF, scr, r, lane); return; } r -= DW_F2;
    if (r < DW_QKV) { transpose_item<1>(P.in[I_WQKV] + (size_t)j * DM * 3 * DM, DM, 3 * DM, (bf16*)(ws + WS_WQKV) + (size_t)j * 3 * DM * DM, scr, r, lane); return; } r -= DW_QKV;
    transpose_item<0>(P.in[I_WO] + (size_t)j * DM * DM, DM, DM, (bf16*)(ws + WS_WO) + (size_t)j * DM * DM, scr, r, lane);
}

DI void prologue_phase(const Ptrs& P, LAS unsigned char* lds, int vcu, int G) {
    const int tid = opaque_tid(), lane = tid & 63, wave = __builtin_amdgcn_readfirstlane(tid >> 6);
    unsigned char* ws = P.ws;
    LAS float* scr = (LAS float*)(lds + wave * 16384);
    const int gw = vcu * 8 + wave, NGW = G * 8;
    for (int it = gw; it < DW_PER_J; it += NGW) dense_weight_item(P, scr, 0, it, lane);
    for (int idx = vcu * 512 + tid; idx < 2 * 2048 * 32; idx += G * 512) {
        const int k8 = idx & 31, row = (idx >> 5) & 2047, j = idx >> 16;
        const int pn = row >> 8, p = row & 255, d = pn >> 2, cg = pn & 3, half = p >> 7, ch = 128 * cg + (p & 127), n = ch >> 6, jj = ch & 63, k0 = 256 * (cg >> 1);
        const float* wsrc = P.in[half ? I_WX : I_WA] + (size_t)((j * 2 + d) * 8 + n) * 4096;
        float v[8];
#pragma unroll
        for (int e = 0; e < 8; ++e) { const int ic = k0 + k8 * 8 + e; v[e] = ((ic >> 6) == n) ? wsrc[(ic & 63) * 64 + jj] : 0.f; }
        u32x4 o; o.x = cvtpk(v[0], v[1]); o.y = cvtpk(v[2], v[3]); o.z = cvtpk(v[4], v[5]); o.w = cvtpk(v[6], v[7]);
        *(u32x4*)((bf16*)(ws + WS_WG) + (size_t)j * 2048 * 256 + (size_t)row * 256 + k8 * 8) = o;
    }
    for (int idx = vcu * 512 + tid; idx < 2 * 2 * 512; idx += G * 512) {
        const int col = idx & 511, d = (idx >> 9) & 1, j = idx >> 10;
        const float l0 = P.in[I_LBLOG][(0 * 2 + d) * 512 + col], l1 = P.in[I_LBLOG][(1 * 2 + d) * 512 + col];
        const float lb = (j == 0) ? 0.f : 1.f / (1.f + __expf(l0 - l1));
        float* t = (float*)(ws + WS_LBT) + (size_t)((j * 2 + d) * 3) * 512 + col;
        t[0] = 1.f - lb; t[512] = fmaxf(lb, 1e-30f); t[1024] = 0.f;
        ((float*)(ws + WS_LBT + 65536))[idx] = 8.0f * logsigmoid_(P.in[I_LAM][idx]);
    }
    __syncthreads();
    LAS float* SC = (LAS float*)lds; LAS float* PART = (LAS float*)(lds + 40960);
    for (int idx = tid; idx < 9 * 1024; idx += 512) { const int r = idx >> 10, k = idx & 1023; const float v = r < 8 ? P.in[I_C][r * 1024 + k] : P.in[I_CCTX][k]; SC[idx] = silu_(v); }
    __syncthreads();
    for (int item = vcu; item < 4 * 96; item += G) {
        const int l = item / 96, cb = item - l * 96;
        const float* wp = P.in[I_WMOD] + (size_t)l * DM * 6144 + (size_t)(wave * 128) * 6144 + 64 * cb + lane;
        float acc[9];
#pragma unroll
        for (int r = 0; r < 9; ++r) acc[r] = 0.f;
        for (int k = 0; k < 128; k += 64) {
            float wv[64];
#pragma unroll
            for (int u = 0; u < 64; ++u) wv[u] = wp[(size_t)(k + u) * 6144];
#pragma unroll
            for (int u = 0; u < 64; ++u)
#pragma unroll
                for (int r = 0; r < 9; ++r) acc[r] += SC[r * 1024 + wave * 128 + k + u] * wv[u];
        }
#pragma unroll
        for (int r = 0; r < 9; ++r) PART[(wave * 9 + r) * 64 + lane] = acc[r];
        __syncthreads();
        for (int idx = tid; idx < 576; idx += 512) { const int r = idx >> 6, col = idx & 63; float s = 0.f;
#pragma unroll
            for (int w2 = 0; w2 < 8; ++w2) s += PART[(w2 * 9 + r) * 64 + col];
            ((float*)(ws + WS_MOD))[(size_t)(l * 9 + r) * 6144 + 64 * cb + col] = s + P.in[I_BMOD][l * 6144 + 64 * cb + col]; }
        __syncthreads();
    }
}

constexpr int CW_TAIL = 71104;
constexpr int CW_TAILQ = 71168;
constexpr int CW_SUB = 71040;
constexpr int CW_Q = 70016;
DI void moe_convert_queue(const Ptrs& P, LAS unsigned char* lds, int j, int maxpulls) {
    const int tid = opaque_tid(), lane = tid & 63, wave = __builtin_amdgcn_readfirstlane(tid >> 6);
    LAS float* scr = (LAS float*)(lds + wave * 16384);
    LAS int* qs = (LAS int*)(lds + RING_BYTES + 64);
    unsigned* head = (unsigned*)(P.ws + WS_CTL) + CW_Q + 64 * j;
    constexpr int I_F1 = 16 * (DFF / 64), I_F2 = (DFF / 64) * 16, PER_E = 2 * I_F1 + I_F2, NIT = NEXP * PER_E;
    const int nit = NIT + (j == 0 ? DW_PER_J : 0);
    for (int pull = 0; pull < maxpulls; ++pull) {
        __syncthreads();
        if (tid == 0) *qs = (int)__hip_atomic_fetch_add(head, 1u, __ATOMIC_RELAXED, __HIP_MEMORY_SCOPE_AGENT);
        __syncthreads();
        const int base = *qs * 32;
        if (base >= nit) break;
        for (int k = 0; k < 4; ++k) {
            const int it = base + k * 8 + wave;
            if (it >= nit) break;
            if (it >= NIT) { dense_weight_item(P, scr, 1, it - NIT, lane); continue; }
            const int e = it / PER_E; int r = it - e * PER_E; const size_t wo = (size_t)(j * NEXP + e) * DM * DFF;
            bf16* b13 = (bf16*)(P.ws + WS_MW13) + (size_t)e * 2 * DFF * DM; bf16* b2 = (bf16*)(P.ws + WS_MW2) + (size_t)e * DM * DFF;
            if (r < I_F1) { transpose_item<2>(P.in[I_MW1] + wo, DM, DFF, b13, scr, r, lane); continue; } r -= I_F1;
            if (r < I_F1) { transpose_item<3>(P.in[I_MW3] + wo, DM, DFF, b13, scr, r, lane); continue; } r -= I_F1;
            transpose_item<0>(P.in[I_MW2] + wo, DFF, DM, b2, scr, r, lane);
        }
    }
    __syncthreads();
}

template <bool ROUTER, bool FIRST>
DI void norm_phase(const Ptrs& P, int vcu, int G, int layer, int which, bool combine, bool latonly, int npart, bool hasd) {
    constexpr int NB = ROUTER ? 2 : 3;
    const int tid = opaque_tid(), lane = tid & 63, wave = __builtin_amdgcn_readfirstlane(tid >> 6);
    unsigned char* ws = P.ws;
    bf16* R = (bf16*)(ws + WS_R); bf16* U = (bf16*)(ws + WS_U);
    const float* MOD = (const float*)(ws + WS_MOD);
    const float* gsrc = P.in[which ? I_NFFNG : I_NMIXG] + layer * DM;
    const bf16* Y32 = (const bf16*)(ws + WS_AR + AR_Y32); const bf16* Y2t = (const bf16*)(ws + WS_PART);
    const unsigned* yflag = (const unsigned*)(ws + WS_CTL) + CW_YF + 1024 * ((layer - 1) >> 1);
    const int* SLOT = (const int*)(ws + WS_SLOT); const float* TOPW = (const float*)(ws + WS_TOPW);
    const bf16* Dd = (const bf16*)(ws + WS_D);
    f32x4 gv[4];
#pragma unroll
    for (int jx = 0; jx < 4; ++jx) gv[jx] = *(const f32x4*)(gsrc + 256 * jx + 4 * lane);
    f32x4 wr0[ROUTER ? 16 : 1], wr1[ROUTER ? 16 : 1];
    if (ROUTER) {
        const float* wrp = P.in[I_ROUTER] + (size_t)(layer >> 1) * DM * NEXP;
#pragma unroll
        for (int jx = 0; jx < 4; ++jx)
#pragma unroll
            for (int e4 = 0; e4 < 4; ++e4) { const float* p = wrp + (size_t)(256 * jx + 4 * lane + e4) * 8; wr0[jx * 4 + e4] = *(const f32x4*)p; wr1[jx * 4 + e4] = *(const f32x4*)(p + 4); }
    }
    const int nper = latonly ? 8 : 9;
    for (int vw = vcu * 8 + wave; vw < 2048; vw += G * 8) {
        int cnt[8];
#pragma unroll
        for (int e = 0; e < 8; ++e) cnt[e] = 0;
        for (int i0 = 0; i0 < nper; i0 += NB) {
            f32x4 xf[FIRST ? NB : 1][4]; u32x2 rr[FIRST ? 1 : NB][4], dd[NB][4], ya[NB][4], yb[NB][4];
            int sl0[NB], sl1[NB]; float tw0[NB], tw1[NB];
#pragma unroll
            for (int q = 0; q < NB; ++q) { sl0[q] = 0; sl1[q] = 0; tw0[q] = 0.f; tw1[q] = 0.f;
                if (combine && i0 + q < nper) { const int row = vw * nper + i0 + q; sl0[q] = SLOT[2 * row]; sl1[q] = SLOT[2 * row + 1]; tw0[q] = TOPW[2 * row]; tw1[q] = TOPW[2 * row + 1]; } }
#pragma unroll
            for (int q = 0; q < NB; ++q) {
                if (i0 + q < nper) {
                    const int tok = vw * nper + i0 + q;
                    const int row = latonly ? tok + 256 * ((tok >> 11) + 1) : tok;
                    if (FIRST) { const int b = row / TB, s = row - b * TB; const bool isctx = s < CTXL;
                        const float* src = isctx ? P.in[I_CTX] + (size_t)(b * CTXL + s) * DM : P.in[I_X] + (size_t)(b * SEQ + s - CTXL) * DM;
#pragma unroll
                        for (int jx = 0; jx < 4; ++jx) xf[FIRST ? q : 0][jx] = *(const f32x4*)(src + 256 * jx + 4 * lane);
                    } else {
#pragma unroll
                        for (int jx = 0; jx < 4; ++jx) rr[FIRST ? 0 : q][jx] = *(const u32x2*)(R + (size_t)row * DM + 256 * jx + 4 * lane);
                    }
                    if (hasd) {
#pragma unroll
                        for (int jx = 0; jx < 4; ++jx) dd[q][jx] = *(const u32x2*)(Dd + (size_t)row * DM + 256 * jx + 4 * lane);
                    }
                    if (combine) {
#pragma unroll
                        for (int jx = 0; jx < 4; ++jx) { ya[q][jx] = *(const u32x2*)(Y32 + (size_t)sl0[q] * DM + 256 * jx + 4 * lane); yb[q][jx] = *(const u32x2*)(Y32 + (size_t)sl1[q] * DM + 256 * jx + 4 * lane); }
                    }
                }
            }
#pragma unroll
            for (int q = 0; q < NB; ++q) {
                if (i0 + q < nper) {
                    const int tok = vw * nper + i0 + q;
                    const int row = latonly ? tok + 256 * ((tok >> 11) + 1) : tok;
                    const int b = row / TB, s = row - b * TB; const bool isctx = s < CTXL; const int mrow = isctx ? 8 : b;
                    f32x4 v[4];
#pragma unroll
                    for (int jx = 0; jx < 4; ++jx) { if (FIRST) v[jx] = xf[FIRST ? q : 0][jx]; else { const u32x2 rw = rr[FIRST ? 0 : q][jx]; v[jx] = (f32x4){bflo(rw.x), bfhi(rw.x), bflo(rw.y), bfhi(rw.y)}; } }
                    if (combine) {
                        const int s0 = sl0[q], s1 = sl1[q]; const float w0 = tw0[q], w1 = tw1[q];
                        const float* gt = MOD + (size_t)((layer - 1) * 9 + mrow) * 6144 + 5 * 1024;
#pragma unroll
                        for (int jx = 0; jx < 4; ++jx) { const u32x2 a0 = ya[q][jx], a1 = yb[q][jx];
                            f32x4 y0 = {bflo(a0.x), bfhi(a0.x), bflo(a0.y), bfhi(a0.y)}, y1 = {bflo(a1.x), bfhi(a1.x), bflo(a1.y), bfhi(a1.y)};
                            const unsigned f0 = yflag[(s0 >> 8) * 4 + jx], f1 = yflag[(s1 >> 8) * 4 + jx];
                            if (f0) { const u32x2 t = *(const u32x2*)(Y2t + (size_t)(f0 - 1) * 65536 + (s0 & 255) * 256 + 4 * lane); y0 = y0 + (f32x4){bflo(t.x), bfhi(t.x), bflo(t.y), bfhi(t.y)}; }
                            if (f1) { const u32x2 t = *(const u32x2*)(Y2t + (size_t)(f1 - 1) * 65536 + (s1 & 255) * 256 + 4 * lane); y1 = y1 + (f32x4){bflo(t.x), bfhi(t.x), bflo(t.y), bfhi(t.y)}; }
                            v[jx] = v[jx] + *(const f32x4*)(gt + 256 * jx + 4 * lane) * (w0 * y0 + w1 * y1); }
                    }
                    if (hasd) {
#pragma unroll
                        for (int jx = 0; jx < 4; ++jx) { const u32x2 dw = dd[q][jx]; v[jx] = v[jx] + (f32x4){bflo(dw.x), bfhi(dw.x), bflo(dw.y), bfhi(dw.y)}; } }
                    const bool addp = (npart > 0) && isctx;
                    if (addp) { const float* pp = (const float*)(ws + WS_PART) + (size_t)(b * CTXL + s) * DM;
                        for (int p = 0; p < npart; ++p)
#pragma unroll
                            for (int jx = 0; jx < 4; ++jx) v[jx] = v[jx] + *(const f32x4*)(pp + (size_t)p * 2048 * DM + 256 * jx + 4 * lane); }
#pragma unroll
                    for (int jx = 0; jx < 4; ++jx) { u32x2 o; o.x = cvtpk(v[jx][0], v[jx][1]); o.y = cvtpk(v[jx][2], v[jx][3]); *(u32x2*)(R + (size_t)row * DM + 256 * jx + 4 * lane) = o; }
                    float ss = 0.f;
#pragma unroll
                    for (int jx = 0; jx < 4; ++jx) ss += (v[jx][0] * v[jx][0] + v[jx][1] * v[jx][1]) + (v[jx][2] * v[jx][2] + v[jx][3] * v[jx][3]);
                    const float rstd = rsqrtf(wave_sum(ss) * (1.f / DM) + EPS);
                    const float* mp = MOD + (size_t)(layer * 9 + mrow) * 6144 + (which ? 3 : 0) * 1024;
                    f32x4 uu[4];
#pragma unroll
                    for (int jx = 0; jx < 4; ++jx) { const f32x4 sh = *(const f32x4*)(mp + 256 * jx + 4 * lane), sc = *(const f32x4*)(mp + 1024 + 256 * jx + 4 * lane);
                        uu[jx] = v[jx] * rstd * gv[jx] * (1.f + sc) + sh;
                        u32x2 o; o.x = cvtpk(uu[jx][0], uu[jx][1]); o.y = cvtpk(uu[jx][2], uu[jx][3]);
                        *(u32x2*)(U + (size_t)row * DM + 256 * jx + 4 * lane) = o; }
                    if (ROUTER) {
                        float lg[8];
#pragma unroll
                        for (int e = 0; e < 8; ++e) lg[e] = 0.f;
#pragma unroll
                        for (int jx = 0; jx < 4; ++jx)
#pragma unroll
                            for (int e4 = 0; e4 < 4; ++e4) { const float uv = uu[jx][e4]; const f32x4 a = wr0[jx * 4 + e4], c2 = wr1[jx * 4 + e4];
                                lg[0] += uv * a[0]; lg[1] += uv * a[1]; lg[2] += uv * a[2]; lg[3] += uv * a[3]; lg[4] += uv * c2[0]; lg[5] += uv * c2[1]; lg[6] += uv * c2[2]; lg[7] += uv * c2[3]; }
#pragma unroll
                        for (int e = 0; e < 8; ++e) lg[e] = wave_sum(lg[e]);
                        int e0 = 0; float v0 = lg[0];
#pragma unroll
                        for (int e = 1; e < 8; ++e) if (lg[e] > v0) { v0 = lg[e]; e0 = e; }
                        int e1 = -1; float v1 = -3.0e38f;
#pragma unroll
                        for (int e = 0; e < 8; ++e) if (e != e0 && lg[e] > v1) { v1 = lg[e]; e1 = e; }
                        e0 = __builtin_amdgcn_readfirstlane(e0); e1 = __builtin_amdgcn_readfirstlane(e1);
                        const float w0 = 1.f / (1.f + __expf(v1 - v0));
#pragma unroll
                        for (int e = 0; e < 8; ++e) cnt[e] += (e0 == e ? 1 : 0) + (e1 == e ? 1 : 0);
                        if (lane == 0) { ((int*)(ws + WS_TOPE))[tok] = e0 | (e1 << 8); ((float*)(ws + WS_TOPW))[2 * tok] = w0; ((float*)(ws + WS_TOPW))[2 * tok + 1] = 1.f - w0; }
                    }
                }
            }
        }
        if (ROUTER) {
            int c = 0;
#pragma unroll
            for (int e = 0; e < 8; ++e) c = (lane == e) ? cnt[e] : c;
            if (lane < 8) ((int*)(ws + WS_WCNT))[vw * 8 + lane] = c;
        }
    }
}

DI void dispatch_phase(const Ptrs& P, LAS unsigned char* lds, int vcu, int G, bool latonly) {
    const int tid = opaque_tid(), lane = tid & 63, wave = __builtin_amdgcn_readfirstlane(tid >> 6);
    unsigned char* ws = P.ws;
    const int* WCNT = (const int*)(ws + WS_WCNT); const int* TOPE = (const int*)(ws + WS_TOPE);
    int* SLOT = (int*)(ws + WS_SLOT); const bf16* U = (const bf16*)(ws + WS_U); bf16* UG = (bf16*)(ws + WS_AR + AR_UG);
    LAS int* TOTL = (LAS int*)(lds + 65536 + 8192); LAS int* PREL = TOTL + 8;
    const int nper = latonly ? 8 : 9;
    for (int vg = vcu; vg < 256; vg += G) {
        __syncthreads();
        {
            const int e = wave; int full = 0, part = 0; int cvv[32];
#pragma unroll
            for (int i = 0; i < 32; ++i) cvv[i] = WCNT[(32 * lane + i) * 8 + e];
#pragma unroll
            for (int i = 0; i < 32; ++i) { const int vw = 32 * lane + i; full += cvv[i]; part += (vw < 8 * vg) ? cvv[i] : 0; }
            full = (int)wave_sum((float)full); part = (int)wave_sum((float)part);
            if (lane == 0) { TOTL[e] = full; PREL[e] = part; }
        }
        int wpre = ((lane >> 3) < wave) ? WCNT[vg * 64 + lane] : 0;
        wpre += __shfl_xor(wpre, 8); wpre += __shfl_xor(wpre, 16); wpre += __shfl_xor(wpre, 32);
        __syncthreads();
        int start[8]; int base = 0;
#pragma unroll
        for (int e = 0; e < 8; ++e) { const int tot = TOTL[e]; const int st = base + PREL[e] + __builtin_amdgcn_readlane(wpre, e);
            start[e] = __builtin_amdgcn_readfirstlane(st); base += (tot + 255) & ~255; }
        if (vg == 0 && wave == 0) {
            int* TILE = (int*)(ws + WS_CTL) + CW_TILE; int bb = 0;
#pragma unroll
            for (int e = 0; e < 8; ++e) { const int nt = (TOTL[e] + 255) >> 8; for (int t = lane; t < nt; t += 64) TILE[(bb >> 8) + t] = e; bb += nt << 8; }
            if (lane == 0) TILE[160] = bb >> 8;
        }
        const int vw = vg * 8 + wave;
        constexpr int NB = 3;
        for (int i0 = 0; i0 < nper; i0 += NB) {
            int ee[NB]; u32x4 ua[NB], ub[NB];
#pragma unroll
            for (int q = 0; q < NB; ++q) { ee[q] = 0;
                if (i0 + q < nper) { const int tok = vw * nper + i0 + q; const int row = latonly ? tok + 256 * ((tok >> 11) + 1) : tok;
                    ee[q] = TOPE[tok]; ua[q] = *(const u32x4*)(U + (size_t)row * DM + 16 * lane); ub[q] = *(const u32x4*)(U + (size_t)row * DM + 16 * lane + 8); } }
#pragma unroll
            for (int q = 0; q < NB; ++q) {
                if (i0 + q < nper) { const int tok = vw * nper + i0 + q;
                    const int e01 = __builtin_amdgcn_readfirstlane(ee[q]); const int e0 = e01 & 255, e1 = e01 >> 8;
                    int s0 = 0, s1 = 0;
#pragma unroll
                    for (int e = 0; e < 8; ++e) { if (e0 == e) { s0 = start[e]; start[e] += 1; } if (e1 == e) { s1 = start[e]; start[e] += 1; } }
                    if (lane == 0) { SLOT[2 * tok] = s0; SLOT[2 * tok + 1] = s1; }
                    *(u32x4*)(UG + (size_t)s0 * DM + 16 * lane) = ua[q]; *(u32x4*)(UG + (size_t)s0 * DM + 16 * lane + 8) = ub[q];
                    *(u32x4*)(UG + (size_t)s1 * DM + 16 * lane) = ua[q]; *(u32x4*)(UG + (size_t)s1 * DM + 16 * lane + 8) = ub[q]; } }
        }
    }
    __syncthreads();
}

DI void final_phase(const Ptrs& P, int vcu, int G) {
    const int tid = opaque_tid(), lane = tid & 63, wave = __builtin_amdgcn_readfirstlane(tid >> 6);
    unsigned char* ws = P.ws;
    const bf16* R = (const bf16*)(ws + WS_R); const float* MOD = (const float*)(ws + WS_MOD); const bf16* Y32 = (const bf16*)(ws + WS_AR + AR_Y32);
    const bf16* Y2t = (const bf16*)(ws + WS_PART); const unsigned* yflag = (const unsigned*)(ws + WS_CTL) + CW_YF + 1024;
    const int* SLOT = (const int*)(ws + WS_SLOT); const float* TOPW = (const float*)(ws + WS_TOPW);
    constexpr int NB = 2;
    const int stride = G * 8;
    for (int tok0 = vcu * 8 + wave; tok0 < NBATCH * SEQ; tok0 += NB * stride) {
        int sl0[NB], sl1[NB]; float tw0[NB], tw1[NB]; u32x2 ya[NB][4], yb[NB][4], rr[NB][4];
#pragma unroll
        for (int q = 0; q < NB; ++q) { const int tok = tok0 + q * stride; sl0[q] = 0; sl1[q] = 0; tw0[q] = 0.f; tw1[q] = 0.f;
            if (tok < NBATCH * SEQ) { sl0[q] = SLOT[2 * tok]; sl1[q] = SLOT[2 * tok + 1]; tw0[q] = TOPW[2 * tok]; tw1[q] = TOPW[2 * tok + 1]; } }
#pragma unroll
        for (int q = 0; q < NB; ++q) { const int tok = tok0 + q * stride;
            if (tok < NBATCH * SEQ) { const int b = tok >> 11, row = tok + 256 * (b + 1);
#pragma unroll
                for (int jx = 0; jx < 4; ++jx) { const int o = 256 * jx + 4 * lane;
                    ya[q][jx] = *(const u32x2*)(Y32 + (size_t)sl0[q] * DM + o); yb[q][jx] = *(const u32x2*)(Y32 + (size_t)sl1[q] * DM + o); rr[q][jx] = *(const u32x2*)(R + (size_t)row * DM + o); } } }
#pragma unroll
        for (int q = 0; q < NB; ++q) { const int tok = tok0 + q * stride;
            if (tok < NBATCH * SEQ) { const int b = tok >> 11;
                const int s0 = sl0[q], s1 = sl1[q]; const float w0 = tw0[q], w1 = tw1[q];
                const float* gt = MOD + (size_t)(3 * 9 + b) * 6144 + 5 * 1024;
#pragma unroll
                for (int jx = 0; jx < 4; ++jx) { const int o = 256 * jx + 4 * lane;
                    const u32x2 a0 = ya[q][jx], a1 = yb[q][jx], rw = rr[q][jx];
                    f32x4 y0 = {bflo(a0.x), bfhi(a0.x), bflo(a0.y), bfhi(a0.y)}, y1 = {bflo(a1.x), bfhi(a1.x), bflo(a1.y), bfhi(a1.y)};
                    const unsigned f0 = yflag[(s0 >> 8) * 4 + jx], f1 = yflag[(s1 >> 8) * 4 + jx];
                    if (f0) { const u32x2 t = *(const u32x2*)(Y2t + (size_t)(f0 - 1) * 65536 + (s0 & 255) * 256 + 4 * lane); y0 = y0 + (f32x4){bflo(t.x), bfhi(t.x), bflo(t.y), bfhi(t.y)}; }
                    if (f1) { const u32x2 t = *(const u32x2*)(Y2t + (size_t)(f1 - 1) * 65536 + (s1 & 255) * 256 + 4 * lane); y1 = y1 + (f32x4){bflo(t.x), bfhi(t.x), bflo(t.y), bfhi(t.y)}; }
                    *(f32x4*)(P.out + (size_t)tok * DM + o) = (f32x4){bflo(rw.x), bfhi(rw.x), bflo(rw.y), bfhi(rw.y)} + *(const f32x4*)(gt + o) * (w0 * y0 + w1 * y1); } } }
    }
}

DI void conv_phase(const Ptrs& P, int vcu, int G, int jl) {
    unsigned char* ar = P.ws + WS_AR;
    const bf16* XR = (const bf16*)(ar + AR_XR); bf16* XC = (bf16*)(ar + AR_XC);
    const float* cw = P.in[I_CONVW] + (size_t)jl * 4 * 512; const float* cb = P.in[I_CONVB] + (size_t)jl * 512;
    const int tid = opaque_tid(), c4 = (tid & 127) * 4, rgp = tid >> 7;
    f32x4 wt[4];
#pragma unroll
    for (int jt = 0; jt < 4; ++jt) wt[jt] = *(const f32x4*)(cw + jt * 512 + c4);
    const f32x4 bias = *(const f32x4*)(cb + c4);
    for (int blk = vcu; blk < T / 72; blk += G) {
        const int r0 = blk * 72 + rgp * 18; const int b = r0 / TB, s0 = r0 - b * TB;
        u32x2 xw[21];
#pragma unroll
        for (int k = 0; k < 21; ++k) { int row = r0 - 2 + k; row = row < 0 ? 0 : (row > T - 1 ? T - 1 : row); xw[k] = *(const u32x2*)(XR + (size_t)row * HGW + c4); }
#pragma unroll
        for (int i = 0; i < 18; ++i) { const int s = s0 + i; const int lo = s < CTXL ? 0 : CTXL, hi = s < CTXL ? CTXL : TB;
            f32x4 a = bias;
#pragma unroll
            for (int jt = 0; jt < 4; ++jt) { const int ss = s + jt - 2; const bool ok = ss >= lo && ss < hi;
                const unsigned x0 = ok ? xw[i + jt].x : 0u, x1 = ok ? xw[i + jt].y : 0u;
                a = a + wt[jt] * (f32x4){bflo(x0), bfhi(x0), bflo(x1), bfhi(x1)}; }
            u32x2 o; o.x = cvtpk(a[0], a[1]); o.y = cvtpk(a[2], a[3]);
            *(u32x2*)(XC + (size_t)(r0 + i) * HGW + c4) = o; }
    }
}

DI void merge_phase(const Ptrs& P, int vcu, int G, int jl) {
    const int tid = opaque_tid(), lane = tid & 63, wave = __builtin_amdgcn_readfirstlane(tid >> 6);
    unsigned char* ar = P.ws + WS_AR;
    const bf16* OF = (const bf16*)(ar + AR_OF); const bf16* OB = (const bf16*)(ar + AR_OB); const bf16* HF = (const bf16*)(ar + AR_HF); const bf16* HB = (const bf16*)(ar + AR_HB);
    const bf16* GS = (const bf16*)(ar + AR_GS); const bf16* YG = (const bf16*)(ar + AR_YG); bf16* MIX = (bf16*)(ar + AR_MIX);
    const float* on = P.in[I_ONORMG] + (size_t)jl * 512 + 8 * lane;
    float ong[8];
#pragma unroll
    for (int e = 0; e < 8; ++e) ong[e] = on[e];
    constexpr int NB = 3;
    const int stride = G * 8;
    for (int row0 = vcu * 8 + wave; row0 < T; row0 += NB * stride) {
        u32x4 ra[NB], rc[NB], rg[NB], rf[NB], rb[NB], ry[NB];
#pragma unroll
        for (int q = 0; q < NB; ++q) { const int row = row0 + q * stride;
            if (row < T) { const size_t o = (size_t)row * HGW + 8 * lane;
                ra[q] = *(const u32x4*)(OF + o); rc[q] = *(const u32x4*)(OB + o); rg[q] = *(const u32x4*)(GS + o); rf[q] = *(const u32x4*)(HF + o); rb[q] = *(const u32x4*)(HB + o); ry[q] = *(const u32x4*)(YG + o); } }
#pragma unroll
        for (int q = 0; q < NB; ++q) { const int row = row0 + q * stride;
            if (row < T) {
                const u32x4 a = ra[q], c2 = rc[q], g = rg[q], hf = rf[q], hb = rb[q], y = ry[q];
                float hg[8] = {bflo(a.x) + bflo(c2.x), bfhi(a.x) + bfhi(c2.x), bflo(a.y) + bflo(c2.y), bfhi(a.y) + bfhi(c2.y), bflo(a.z) + bflo(c2.z), bfhi(a.z) + bfhi(c2.z), bflo(a.w) + bflo(c2.w), bfhi(a.w) + bfhi(c2.w)};
                const float gg[8] = {bflo(g.x), bfhi(g.x), bflo(g.y), bfhi(g.y), bflo(g.z), bfhi(g.z), bflo(g.w), bfhi(g.w)};
                float ss = 0.f;
#pragma unroll
                for (int e = 0; e < 8; ++e) ss += hg[e] * hg[e];
                const float rstd = rsqrtf(wave_sum(ss) * (1.f / 512.f) + EPS);
#pragma unroll
                for (int e = 0; e < 8; ++e) hg[e] = hg[e] * rstd * ong[e] * gg[e];
                u32x4 w; w.x = cvtpk(hg[0], hg[1]); w.y = cvtpk(hg[2], hg[3]); w.z = cvtpk(hg[4], hg[5]); w.w = cvtpk(hg[6], hg[7]);
                *(u32x4*)(MIX + (size_t)row * DM + 8 * lane) = w;
                w.x = cvtpk((bflo(hf.x) + bflo(hb.x)) * bflo(y.x), (bfhi(hf.x) + bfhi(hb.x)) * bfhi(y.x));
                w.y = cvtpk((bflo(hf.y) + bflo(hb.y)) * bflo(y.y), (bfhi(hf.y) + bfhi(hb.y)) * bfhi(y.y));
                w.z = cvtpk((bflo(hf.z) + bflo(hb.z)) * bflo(y.z), (bfhi(hf.z) + bfhi(hb.z)) * bfhi(y.z));
                w.w = cvtpk((bflo(hf.w) + bflo(hb.w)) * bflo(y.w), (bfhi(hf.w) + bfhi(hb.w)) * bfhi(y.w));
                *(u32x4*)(MIX + (size_t)row * DM + 512 + 8 * lane) = w;
            } }
    }
}

DI int tau_row(int tau, int d) { return tau < CTXL ? (d ? CTXL - 1 - tau : tau) : CTXL + (d ? SEQ - 1 - (tau - CTXL) : (tau - CTXL)); }

DI void rg_coeff(float ra, float ix, float xc, float lsl, float& la, float& bb) {
    la = sigmoid_(ra) * lsl;
    const float y = 2.f * la;
    const float ser = -y * (1.f + y * (0.5f + y * (0.16666667f + y * (0.041666667f + y * 0.0083333333f))));
    const float om = (y > -0.3f) ? ser : 1.f - __expf(y);
    bb = __builtin_amdgcn_sqrtf(fmaxf(om, 0.f)) * (sigmoid_(ix) * xc);
}
DI void rgscan_item(LAS unsigned char* lds, int item, unsigned char* ar, const float* lslp) {
    const int tid = opaque_tid(), lane = tid & 63, w = __builtin_amdgcn_readfirstlane(tid >> 6);
    const int d = item >> 6, b = (item >> 3) & 7, cb = item & 7, ch = 64 * cb + lane;
    bf16* RA = (bf16*)(ar + (d ? AR_LAB : AR_LAF)); bf16* IX = (bf16*)(ar + (d ? AR_BBB : AR_BBF)); const bf16* XC = (const bf16*)(ar + AR_XC); bf16* HD = (bf16*)(ar + (d ? AR_HB : AR_HF));
    const float lsl = lslp[d * 512 + ch];
    LAS float* SEG = (LAS float*)lds;
    const int tau0 = 288 * w;
    float h = 0.f, sla = 0.f;
#define RG_ROW(tt) ((size_t)(b * TB + tau_row(tau0 + (tt), d)) * HGW)
    const unsigned chu = (unsigned)ch;
    typedef const __attribute__((address_space(1))) bf16* gcptr; typedef __attribute__((address_space(1))) bf16* gptr;
    auto sp = [](const bf16* q0) { gcptr q = (gcptr)q0; asm volatile("" : "+s"(q)); return q; };
    auto spw = [](bf16* q0) { gptr q = (gptr)q0; asm volatile("" : "+s"(q)); return q; };
#define RG_USE(S) asm volatile("" :: "v"((unsigned)S[0]), "v"((unsigned)S[1]), "v"((unsigned)S[2]), "v"((unsigned)S[3]), "v"((unsigned)S[4]), "v"((unsigned)S[5]), "v"((unsigned)S[6]), "v"((unsigned)S[7]), \
        "v"((unsigned)S[8]), "v"((unsigned)S[9]), "v"((unsigned)S[10]), "v"((unsigned)S[11]), "v"((unsigned)S[12]), "v"((unsigned)S[13]), "v"((unsigned)S[14]), "v"((unsigned)S[15]))
#define RG_LD1(Sr, Sx, Sc, tb) do { _Pragma("unroll") for (int i = 0; i < 16; ++i) { const size_t o = RG_ROW((tb) + i); Sr[i] = sp(RA + o)[chu]; Sx[i] = sp(IX + o)[chu]; Sc[i] = sp(XC + o)[chu]; } } while (0)
#define RG_CP1(Sr, Sx, Sc, tb) do { _Pragma("unroll") for (int i = 0; i < 16; ++i) { const size_t o = RG_ROW((tb) + i); \
            const float la = sigmoid_(bf2f(Sr[i])) * lsl;                                    \
            const unsigned short lab = bfbits(la); const float laq = bf2f(lab); const float a = __expf(laq); \
            const float bb = __builtin_amdgcn_sqrtf(fmaxf((1.f - a) * (1.f + a), 0.f)) * (sigmoid_(bf2f(Sx[i])) * bf2f(Sc[i]));     \
            const unsigned short bbb = bfbits(bb); spw(RA + o)[chu] = lab; spw(IX + o)[chu] = bbb;      \
            h = a * h + bf2f(bbb); sla += laq; } } while (0)
    {
        unsigned short Ar[16], Ax[16], Ac[16], Br[16], Bx[16], Bc[16];
        RG_LD1(Ar, Ax, Ac, 0);
        for (int t0 = 0; t0 < 288; t0 += 32) {
            RG_USE(Ar); RG_USE(Ax); RG_USE(Ac);
            RG_LD1(Br, Bx, Bc, t0 + 16);
            RG_CP1(Ar, Ax, Ac, t0);
            RG_USE(Br); RG_USE(Bx); RG_USE(Bc);
            if (t0 + 32 < 288) RG_LD1(Ar, Ax, Ac, t0 + 32);
            RG_CP1(Br, Bx, Bc, t0 + 16);
        }
    }
    __syncthreads();
    SEG[(w * 2 + 0) * 64 + lane] = sla; SEG[(w * 2 + 1) * 64 + lane] = h;
    __syncthreads();
    h = 0.f;
    for (int w2 = 0; w2 < w; ++w2) h = __expf(SEG[(w2 * 2 + 0) * 64 + lane]) * h + SEG[(w2 * 2 + 1) * 64 + lane];
#define RG_LD2(Sl, Sb, tb) do { _Pragma("unroll") for (int i = 0; i < 16; ++i) { const size_t o = RG_ROW((tb) + i); Sl[i] = sp(RA + o)[chu]; Sb[i] = sp(IX + o)[chu]; } } while (0)
#define RG_CP2(Sl, Sb, tb) do { _Pragma("unroll") for (int i = 0; i < 16; ++i) { const size_t o = RG_ROW((tb) + i); h = __expf(bf2f(Sl[i])) * h + bf2f(Sb[i]); spw(HD + o)[chu] = bfbits(h); } } while (0)
    {
        unsigned short Al[16], Ab[16], Bl[16], Bb[16];
        RG_LD2(Al, Ab, 0);
        for (int t0 = 0; t0 < 288; t0 += 32) {
            RG_USE(Al); RG_USE(Ab);
            RG_LD2(Bl, Bb, t0 + 16);
            RG_CP2(Al, Ab, t0);
            RG_USE(Bl); RG_USE(Bb);
            if (t0 + 32 < 288) RG_LD2(Al, Ab, t0 + 32);
            RG_CP2(Bl, Bb, t0 + 16);
        }
    }
#undef RG_ROW
#undef RG_USE
#undef RG_LD1
#undef RG_CP1
#undef RG_LD2
#undef RG_CP2
}

DI void gla_item(LAS unsigned char* lds, int item, unsigned char* ar) {
    const int tid = opaque_tid(), lane = tid & 63, w = __builtin_amdgcn_readfirstlane(tid >> 6);
    const int head = item & 3, b = (item >> 2) & 7, d = item >> 5;
    const bf16* Qh = (const bf16*)(ar + AR_QH); const bf16* KK = (const bf16*)(ar + (d ? AR_KKB : AR_KKF)); const bf16* LF = (const bf16*)(ar + (d ? AR_LFB : AR_LFF));
    const bf16* Vv = (const bf16*)(ar + AR_VV); bf16* Od = (bf16*)(ar + (d ? AR_OB : AR_OF));
    constexpr int RS = 272, BUF = 36864, QS = 0, QM = 8704, KM = 17408, VI = 26112, FAC = 34816, TOTP = 2 * BUF, NCH = 72;
    constexpr float L2E = 1.4426950408889634f;
    const int r = lane & 31, h = lane >> 5, blk = (lane >> 4) & 1, q4 = (lane & 15) >> 2, p4 = lane & 3;
    const int ptid = tid & 255, cp = ptid & 63, hh = __builtin_amdgcn_readfirstlane((ptid >> 6) & 1), pp = __builtin_amdgcn_readfirstlane(ptid >> 7);
    const unsigned colq = head * 128 + 2 * cp;
    const int kperm = (2 * cp & ~12) | ((2 * cp & 4) << 1) | ((2 * cp & 8) >> 1);
    const int p128 = ptid & 127, vrow = p128 >> 2; const unsigned vcol = head * 128 + (p128 & 3) * 32;
#define GLA_BASE(n) ((n) < 8 ? 32 * (d ? 7 - (n) : (n)) : CTXL + 32 * (d ? 63 - ((n) - 8) : ((n) - 8)))
#define GLA_ROW(base, i) (b * TB + (d ? (base) + 31 - (i) : (base) + (i)))
#define GLA_LOAD(n) do { const int _bs = GLA_BASE(n); _Pragma("unroll") for (int i = 0; i < 16; ++i) { \
        const unsigned _o = (unsigned)GLA_ROW(_bs, 16 * hh + i) * HGW + colq; \
        lfw[i] = *(const unsigned*)(LF + _o); qv[i] = *(const unsigned*)(Qh + _o); kv[i] = *(const unsigned*)(KK + _o); } \
        const bf16* _vp = Vv + (unsigned)GLA_ROW(_bs, vrow) * HGW + vcol; \
        vr[0] = *(const u32x4*)_vp; vr[1] = *(const u32x4*)(_vp + 8); vr[2] = *(const u32x4*)(_vp + 16); vr[3] = *(const u32x4*)(_vp + 24); } while (0)
#define GLA_PREPA() do { float r0 = 0.f, r1 = 0.f; _Pragma("unroll") for (int i = 0; i < 16; ++i) { r0 += bflo(lfw[i]) * L2E; r1 += bfhi(lfw[i]) * L2E; lf[i][0] = r0; lf[i][1] = r1; } \
        *(LAS f32x2*)(lds + TOTP + ((pp * 2 + hh) * 64 + cp) * 8) = (f32x2){r0, r1}; } while (0)
#define GLA_PREPB(pbuf) do { LAS unsigned char* _B = lds + (pbuf) * BUF; \
        const f32x2 t0 = *(const LAS f32x2*)(lds + TOTP + ((pp * 2 + 0) * 64 + cp) * 8), t1 = *(const LAS f32x2*)(lds + TOTP + ((pp * 2 + 1) * 64 + cp) * 8); \
        const f32x2 bmid = t0, blast = t0 + t1; \
        const f32x2 pre = hh ? t0 : (f32x2){0.f, 0.f}; \
        const float em0 = __builtin_amdgcn_exp2f(bmid[0]), em1 = __builtin_amdgcn_exp2f(bmid[1]); \
        _Pragma("unroll") for (int i = 0; i < 16; ++i) { const float b0 = pre[0] + lf[i][0], b1 = pre[1] + lf[i][1]; \
            const float e10 = __builtin_amdgcn_exp2f(fminf(b0 - bmid[0], 100.f)), e11 = __builtin_amdgcn_exp2f(fminf(b1 - bmid[1], 100.f)); \
            const float e20 = __builtin_amdgcn_exp2f(fminf(bmid[0] - b0, 100.f)), e21 = __builtin_amdgcn_exp2f(fminf(bmid[1] - b1, 100.f)); \
            const float qm0 = bflo(qv[i]) * e10, qm1 = bfhi(qv[i]) * e11; const int _ro = (16 * hh + i) * RS; \
            *(LAS unsigned*)(_B + QM + _ro + 4 * cp) = cvtpk(qm0, qm1); *(LAS unsigned*)(_B + QS + _ro + 2 * kperm) = cvtpk(qm0 * em0, qm1 * em1); \
            *(LAS unsigned*)(_B + KM + _ro + 4 * cp) = cvtpk(bflo(kv[i]) * e20, bfhi(kv[i]) * e21); } \
        if (hh) { *(LAS f32x2*)(_B + FAC + 8 * cp) = (f32x2){__builtin_amdgcn_exp2f(blast[0]), __builtin_amdgcn_exp2f(blast[1])}; \
                  *(LAS f32x2*)(_B + FAC + 512 + 8 * cp) = (f32x2){__builtin_amdgcn_exp2f(blast[0] - bmid[0]), __builtin_amdgcn_exp2f(blast[1] - bmid[1])}; } \
        _Pragma("unroll") for (int q = 0; q < 4; ++q) *(LAS u32x4*)(_B + VI + vrow * RS + (p128 & 3) * 64 + 16 * q) = vr[q]; } while (0)
#define GLA_BAR() do { asm volatile("s_waitcnt lgkmcnt(0)" ::: "memory"); __builtin_amdgcn_s_barrier(); asm volatile("" ::: "memory"); } while (0)
    __syncthreads();
    if (w >= 4) {
        f32x2 lf[16]; unsigned lfw[16], qv[16], kv[16]; u32x4 vr[4];
        if (pp == 0) GLA_LOAD(0);
        for (int p = -2; p < NCH; ++p) {
            if (((p + 1) & 1) == pp) { if (p + 1 >= 0 && p + 1 < NCH) GLA_PREPB((p + 1) & 1); if (p + 3 < NCH) GLA_LOAD(p + 3); }
            else { if (p + 2 < NCH) GLA_PREPA(); }
            GLA_BAR();
        }
    } else {
        f32x16 st[4];
#pragma unroll
        for (int kt = 0; kt < 4; ++kt)
#pragma unroll
            for (int i = 0; i < 16; ++i) st[kt][i] = 0.f;
        const int vt = w;
        GLA_BAR(); GLA_BAR();
        for (int n = 0; n < NCH; ++n) {
            const LAS unsigned char* B = lds + (n & 1) * BUF;
            const int base = GLA_BASE(n);
            f32x16 o, x;
#pragma unroll
            for (int i = 0; i < 16; ++i) { o[i] = 0.f; x[i] = 0.f; }
#pragma unroll
            for (int kt = 0; kt < 4; ++kt)
#pragma unroll
                for (int sx = 0; sx < 2; ++sx) {
                    const bf16x8 qa = *(const LAS bf16x8*)(B + QS + r * RS + (32 * kt + 16 * sx + 8 * h) * 2);
                    o = MFMA32(pack8(st[kt], sx), qa, o);
                }
#pragma unroll
            for (int ks = 0; ks < 8; ++ks) {
                const bf16x8 a = *(const LAS bf16x8*)(B + KM + r * RS + (16 * ks + 8 * h) * 2);
                const bf16x8 bq = *(const LAS bf16x8*)(B + QM + r * RS + (16 * ks + 8 * h) * 2);
                x = MFMA32(a, bq, x);
            }
#pragma unroll
            for (int i = 0; i < 16; ++i) x[i] = (crow(i, h) > r) ? 0.f : x[i];
#pragma unroll
            for (int sx = 0; sx < 2; ++sx) {
                const LAS unsigned char* vp = B + VI + (16 * sx + 4 * h + q4) * RS + (32 * vt + 16 * blk) * 2 + 8 * p4;
                o = MFMA32(cat8(vtr(vp), vtr(vp + 8 * RS)), pack8(x, sx), o);
            }
            bf16x8 bv[2];
#pragma unroll
            for (int ss = 0; ss < 2; ++ss) { const LAS unsigned char* vp = B + VI + (16 * ss + 8 * h + q4) * RS + (32 * vt + 16 * blk) * 2 + 8 * p4; bv[ss] = cat8(vtr(vp), vtr(vp + 4 * RS)); }
#pragma unroll
            for (int kt = 0; kt < 4; ++kt) {
                f32x16 t;
#pragma unroll
                for (int i = 0; i < 16; ++i) t[i] = 0.f;
#pragma unroll
                for (int ss = 0; ss < 2; ++ss) { const LAS unsigned char* kp = B + KM + (16 * ss + 8 * h + q4) * RS + (32 * kt + 16 * blk) * 2 + 8 * p4;
                    t = MFMA32(cat8(vtr(kp), vtr(kp + 4 * RS)), bv[ss], t); }
#pragma unroll
                for (int g4 = 0; g4 < 4; ++g4) {
                    const f32x4 dl = *(const LAS f32x4*)(B + FAC + (32 * kt + 8 * g4 + 4 * h) * 4), fl = *(const LAS f32x4*)(B + FAC + 512 + (32 * kt + 8 * g4 + 4 * h) * 4);
#pragma unroll
                    for (int e = 0; e < 4; ++e) st[kt][4 * g4 + e] = dl[e] * st[kt][4 * g4 + e] + fl[e] * t[4 * g4 + e];
                }
            }
            {
                bf16* op = Od + (size_t)GLA_ROW(base, r) * HGW + head * 128 + 32 * vt + 4 * h;
#pragma unroll
                for (int g4 = 0; g4 < 4; ++g4) { u32x2 wv; wv.x = cvtpk(o[4 * g4], o[4 * g4 + 1]); wv.y = cvtpk(o[4 * g4 + 2], o[4 * g4 + 3]); *(u32x2*)(op + 8 * g4) = wv; }
            }
            GLA_BAR();
        }
    }
    __syncthreads();
#undef GLA_BAR
#undef GLA_BASE
#undef GLA_ROW
#undef GLA_LOAD
#undef GLA_PREPA
#undef GLA_PREPB
}

DI void attn_item(LAS unsigned char* lds, int it, unsigned char* ar, const float* rpb) {
    const int tid = opaque_tid(), lane = tid & 63, w = __builtin_amdgcn_readfirstlane(tid >> 6);
    const int r = lane & 31, h = lane >> 5, blk = (lane >> 4) & 1, q4 = (lane & 15) >> 2, p4 = lane & 3;
    const bool isctx = it >= 1024;
    int b, head, rg;
    if (!isctx) { b = it >> 7; head = (it >> 3) & 15; rg = it & 7; } else { const int c = it - 1024; b = c >> 4; head = c & 15; rg = 0; }
    const bf16* Qb = (const bf16*)(ar + AR_QB); const bf16* Kb = (const bf16*)(ar + AR_KB); const bf16* Vb = (const bf16*)(ar + AR_VB); bf16* AO = (bf16*)(ar + AR_AO);
    constexpr int KS = 144, K0 = 0, V0 = 9216, K1 = 18432, V1 = 27648, RPBO = 36864;
    constexpr float L2E = 1.4426950408889634f;
    LAS float* RPBp = (LAS float*)(lds + RPBO);
    __syncthreads();
    if (!isctx) { const int dr = tid >> 5, dc = tid & 31; RPBp[tid] = (dr < 15 && dc < 31) ? rpb[head * 465 + dr * 31 + dc] * L2E : -INFINITY; }
    const int pr = w >> 2, nb = w & 3;
    const int qr = 4 * rg + 2 * pr + (r >> 4), qcol = 16 * nb + (r & 15);
    const int cst = min(max(16 * nb - 8, 0), 32);
    const int qrow = isctx ? b * TB + 32 * w + r : b * TB + CTXL + qr * 64 + qcol;
    bf16x8 qf[4];
#pragma unroll
    for (int ks = 0; ks < 4; ++ks) qf[ks] = *(const bf16x8*)(Qb + (size_t)qrow * DM + head * 64 + 16 * ks + 8 * h);
    const int rs = min(max(qr - 4, 0), 24);
    const int wr0 = 4 * rg + 2 * pr, wlo = min(max(wr0 - 4, 0), 24), whi = min(max(wr0 - 3, 0), 24) + 8;
    const int lo = isctx ? 0 : min(max(4 * rg - 4, 0), 24), hi = isctx ? 0 : min(max(4 * rg - 1, 0), 24) + 8;
    const int nloc = hi - lo, nst = nloc + 4;
    const int skey = tid >> 3, sch = tid & 7;
    const int wst = min(max(qcol - 8, 0), 48);
    int dco[16];
#pragma unroll
    for (int i = 0; i < 16; ++i) { const int kcol = cst + crow(i, h); const bool valid = (kcol >= wst) && (kcol < wst + 16); dco[i] = valid ? 4 * (kcol - qcol + 15) : 4 * 31; }
    u32x4 kA, vA, kB, vB;
#define ATT_KROW(s) ((s) < nloc ? b * TB + CTXL + (lo + (s)) * 64 + skey : b * TB + ((s) - nloc) * 64 + skey)
#define ATT_LOAD(kr, vr, s) do { const size_t _o = (size_t)ATT_KROW(s) * DM + head * 64 + sch * 8; kr = *(const u32x4*)(Kb + _o); vr = *(const u32x4*)(Vb + _o); } while (0)
#define ATT_STORE(kr, vr, buf) do { *(LAS u32x4*)(lds + ((buf) ? K1 : K0) + skey * KS + sch * 16) = kr; *(LAS u32x4*)(lds + ((buf) ? V1 : V0) + skey * KS + sch * 16) = vr; } while (0)
    float m_run = -INFINITY, l_run = 0.f;
    f32x16 o0, o1;
#pragma unroll
    for (int i = 0; i < 16; ++i) { o0[i] = 0.f; o1[i] = 0.f; }
#define ATT_TILE(Kc, Vc, koff, BIAS) do { \
        f32x16 x; \
        _Pragma("unroll") for (int i = 0; i < 16; ++i) x[i] = 0.f; \
        _Pragma("unroll") for (int ks = 0; ks < 4; ++ks) { const bf16x8 a = *(const LAS bf16x8*)(lds + (Kc) + ((koff) + r) * KS + (16 * ks + 8 * h) * 2); x = MFMA32(a, qf[ks], x); } \
        if (BIAS) { _Pragma("unroll") for (int i = 0; i < 16; ++i) x[i] = x[i] + *(const LAS float*)(brow + dco[i]); } \
        float mx = fmaxf(fmaxf(fmaxf(x[0], x[1]), fmaxf(x[2], x[3])), fmaxf(fmaxf(x[4], x[5]), fmaxf(x[6], x[7]))); \
        mx = fmaxf(mx, fmaxf(fmaxf(fmaxf(x[8], x[9]), fmaxf(x[10], x[11])), fmaxf(fmaxf(x[12], x[13]), fmaxf(x[14], x[15])))); \
        mx = fmaxf(mx, __shfl_xor(mx, 32)); \
        const float m_new = fmaxf(m_run, mx), m_use = (m_new == -INFINITY) ? 0.f : m_new; \
        const float alpha = __builtin_amdgcn_exp2f(m_run - m_use); \
        float ps = 0.f; \
        _Pragma("unroll") for (int i = 0; i < 16; ++i) { x[i] = __builtin_amdgcn_exp2f(x[i] - m_use); ps += x[i]; } \
        l_run = l_run * alpha + ps; m_run = m_new; \
        if (__any(alpha != 1.f)) { _Pragma("unroll") for (int i = 0; i < 16; ++i) { o0[i] *= alpha; o1[i] *= alpha; } } \
        _Pragma("unroll") for (int sx = 0; sx < 2; ++sx) { \
            const bf16x8 pb = pack8(x, sx); \
            const LAS unsigned char* vp = lds + (Vc) + ((koff) + 16 * sx + 4 * h + q4) * KS + (16 * blk) * 2 + 8 * p4; \
            const bf16x8 a0 = cat8(vtr(vp), vtr(vp + 8 * KS)); \
            const bf16x8 a1 = cat8(vtr(vp + 64), vtr(vp + 64 + 8 * KS)); \
            o0 = MFMA32(a0, pb, o0); o1 = MFMA32(a1, pb, o1); \
        } } while (0)
#define ATT_COMPUTE(s, Kc, Vc) do { \
        if ((s) < nloc) { const int krow = lo + (s); \
            if (krow >= wlo && krow < whi) { \
                const int dr = (krow >= rs && krow < rs + 8) ? krow - qr + 7 : 15; \
                const LAS unsigned char* brow = lds + RPBO + dr * 128; \
                ATT_TILE(Kc, Vc, cst, true); } \
        } else { const LAS unsigned char* brow = lds; ATT_TILE(Kc, Vc, 0, false); ATT_TILE(Kc, Vc, 32, false); } } while (0)
#define ATT_BAR() do { asm volatile("s_waitcnt lgkmcnt(0)" ::: "memory"); __builtin_amdgcn_s_barrier(); asm volatile("" ::: "memory"); } while (0)
    ATT_LOAD(kA, vA, 0); ATT_STORE(kA, vA, 0); ATT_LOAD(kA, vA, 1);
    ATT_BAR();
    for (int s = 0; s < nst; s += 2) {
        if (s + 2 < nst) ATT_LOAD(kB, vB, s + 2);
        ATT_COMPUTE(s, K0, V0);
        if (s + 1 < nst) ATT_STORE(kA, vA, 1);
        ATT_BAR();
        if (s + 1 >= nst) break;
        if (s + 3 < nst) ATT_LOAD(kA, vA, s + 3);
        ATT_COMPUTE(s + 1, K1, V1);
        if (s + 2 < nst) ATT_STORE(kB, vB, 0);
        ATT_BAR();
    }
#undef ATT_BAR
#undef ATT_COMPUTE
#undef ATT_TILE
    l_run += __shfl_xor(l_run, 32);
    const float inv = __builtin_amdgcn_rcpf(l_run);
#pragma unroll
    for (int g4 = 0; g4 < 4; ++g4) {
        u32x2 w0; w0.x = cvtpk(o0[4 * g4] * inv, o0[4 * g4 + 1] * inv); w0.y = cvtpk(o0[4 * g4 + 2] * inv, o0[4 * g4 + 3] * inv);
        *(u32x2*)(AO + (size_t)qrow * DM + head * 64 + 8 * g4 + 4 * h) = w0;
        u32x2 w1; w1.x = cvtpk(o1[4 * g4] * inv, o1[4 * g4 + 1] * inv); w1.y = cvtpk(o1[4 * g4 + 2] * inv, o1[4 * g4 + 3] * inv);
        *(u32x2*)(AO + (size_t)qrow * DM + head * 64 + 32 + 8 * g4 + 4 * h) = w1;
    }
#undef ATT_KROW
#undef ATT_LOAD
#undef ATT_STORE
}

constexpr int NPH_PAIR = 18, NPHASE = 2 + 2 * NPH_PAIR;
__global__ void __launch_bounds__(512, 2) fwd_kernel(Ptrs P) {
    extern __shared__ __attribute__((aligned(16))) unsigned char lds_raw[];
    LAS unsigned char* lds = (LAS unsigned char*)lds_raw;
    volatile LAS unsigned* MISC = (volatile LAS unsigned*)(lds + MISC_OFF);
    const int tid = threadIdx.x;
    const int G = gridDim.x; const int bx = blockIdx.x; const int vcu = (G % 8 == 0) ? (bx % 8) * (G / 8) + bx / 8 : bx;
    unsigned char* ws = P.ws; unsigned char* ar = ws + WS_AR;
    for (int u = tid; u < (LDS_BYTES - RING_BYTES) / 4; u += 512) ((LAS unsigned*)(lds + RING_BYTES))[u] = 0u;
    __syncthreads();
    if ((tid & 63) == 0) *(volatile LAS int*)(size_t)(TIDTAB_OFF + 4 * hw_wave_slot()) = tid >> 6;
    __syncthreads();
    const int lo = P.ph_lo, hi = P.ph_hi;
    XcdBarrier bar; bar.bar = (unsigned*)(ws + WS_CTL) + CW_BAR; bar.x = 0; bar.st = nullptr;
    if (hi - lo > 1) bar = xcd_barrier_post((unsigned*)(ws + WS_CTL) + CW_BAR, MISC + 8);
#ifndef PH_EN
#define PH_EN 0xFFFFFu
#endif
#define EN(id) (((PH_EN) >> (id)) & 1u)
#ifndef PH_REP
#define PH_REP 0u
#endif
#define REPS(id) (1 + (int)(((PH_REP) >> (id)) & 1u))
#define IN(k) (lo <= (k) && (k) < hi)
#define SEAM(k) do { if ((k) + 1 < hi) xcd_barrier(bar); } while (0)
    const float* MOD = (const float*)(ws + WS_MOD);
    const bf16* U = (const bf16*)(ws + WS_U);
    const int* TILE = (const int*)(ws + WS_CTL) + CW_TILE;

    if (EN(0) && IN(0)) for (int rep = 0; rep < REPS(0); ++rep) { prologue_phase(P, lds, vcu, G); SEAM(0); }

    for (int j = 0; j < 2; ++j) {
        const int pb = 1 + NPH_PAIR * j, LE = 2 * j, LO = 2 * j + 1;
        if (EN(1) && IN(pb + 0)) for (int rep = 0; rep < REPS(1); ++rep) { if (j == 0) norm_phase<false, true>(P, vcu, G, LE, 0, false, false, 0, false); else norm_phase<false, false>(P, vcu, G, LE, 0, true, false, 0, false); SEAM(pb + 0); }
        if (EN(2) && IN(pb + 1)) for (int rep = 0; rep < REPS(2); ++rep) {
            Gemm g{U, (const bf16*)(ws + WS_WIN) + (size_t)j * EVIN * DM, DM, DM, DM}; GOrder S; S.init(T / 256, EVIN / 256, G, bx, 0, nullptr);
            EpiEvenIn E{ar, (const float*)(ws + WS_LBT) + (size_t)j * 2 * 3 * 512};
            pg8::gemm_phase<EpiEvenIn>(lds, g, S, E); SEAM(pb + 1);
        }
        const bool fusedmix = (G == 256) && (hi - lo > 1);
        if (EN(3) && IN(pb + 2) && !fusedmix) for (int rep = 0; rep < REPS(3); ++rep) { conv_phase(P, vcu, G, j); SEAM(pb + 2); }
        if (EN(4) && IN(pb + 3) && !fusedmix) for (int rep = 0; rep < REPS(4); ++rep) {
            Gemm g{(const bf16*)(ar + AR_XC), (const bf16*)(ws + WS_WG) + (size_t)j * 2048 * 256, HGW, 256, 256}; GOrder S; S.init(T / 256, 8, G, bx, 3, nullptr);
            EpiGate E{ar, P.in[I_BA] + (size_t)j * 1024, P.in[I_BX] + (size_t)j * 1024};
            pg8::gemm_phase<EpiGate>(lds, g, S, E); SEAM(pb + 3);
        }
        if (EN(5) && IN(pb + 4)) for (int rep = 0; rep < REPS(5); ++rep) {
            const float* lslp = (const float*)(ws + WS_LBT + 65536) + (size_t)j * 1024;
            if (fusedmix) {
                if (vcu < 64) gla_item(lds, vcu, ar);
                else {
                    unsigned* sc = (unsigned*)(ws + WS_CTL) + CW_SUB;
                    conv_phase(P, vcu - 64, 192, j);
                    sub_barrier(sc, 192u * (unsigned)(2 * j + 1));
                    {
                        Gemm g{(const bf16*)(ar + AR_XC), (const bf16*)(ws + WS_WG) + (size_t)j * 2048 * 256, HGW, 256, 256}; GOrder S; S.init(T / 256, 8, 192, vcu - 64, 3, nullptr);
                        EpiGate E{ar, P.in[I_BA] + (size_t)j * 1024, P.in[I_BX] + (size_t)j * 1024};
                        pg8::gemm_phase<EpiGate>(lds, g, S, E);
                    }
                    sub_barrier(sc, 192u * (unsigned)(2 * j + 2));
                    if (vcu < 192) rgscan_item(lds, vcu - 64, ar, lslp);
                    else moe_convert_queue(P, lds, j, 5);
                }
            } else {
                for (int it = vcu; it < 192; it += G) { if (it < 64) gla_item(lds, it, ar); else rgscan_item(lds, it - 64, ar, lslp); }
                if (rep == 0 && vcu >= 64) moe_convert_queue(P, lds, j, vcu >= 192 ? 3 : 1);
            }
            SEAM(pb + 4);
        }
        if (EN(6) && IN(pb + 5)) for (int rep = 0; rep < REPS(6); ++rep) { merge_phase(P, vcu, G, j); SEAM(pb + 5); }
        if (EN(7) && IN(pb + 6)) for (int rep = 0; rep < REPS(7); ++rep) {
            Gemm g{(const bf16*)(ar + AR_MIX), (const bf16*)(ws + WS_WOUT) + (size_t)j * DM * DM, DM, DM, DM}; GOrder S; S.init(T / 256, 4, G, bx, 0, nullptr);
            EpiResid E{(bf16*)(ws + WS_D), MOD + (size_t)(LE * 9) * 6144 + 2 * 1024};
            pg8::gemm_phase<EpiResid>(lds, g, S, E);
            if (rep == 0 && bx >= 32) moe_convert_queue(P, lds, j, 1);
            SEAM(pb + 6);
        }
        if (EN(8) && IN(pb + 7)) for (int rep = 0; rep < REPS(8); ++rep) { norm_phase<false, false>(P, vcu, G, LE, 1, false, false, 0, true); SEAM(pb + 7); }
        const int nun13 = (T / 256) * (2 * DFF / 256), nfull13 = nun13 / G, ntail13 = nun13 - nfull13 * G;
        const bool fusetail = (G == 256) && (hi - lo > 1) && ntail13 > 0;
        if (EN(9) && IN(pb + 8)) for (int rep = 0; rep < REPS(9); ++rep) {
            Gemm g{U, (const bf16*)(ws + WS_W13) + (size_t)j * 2 * DFF * DM, DM, DM, DM}; GOrder S; S.init(T / 256, 2 * DFF / 256, G, bx, 0, nullptr); if (fusetail) { S.imax = nfull13; S.chunk = true; }
            EpiSwiglu E{(bf16*)(ar + AR_HID), DFF};
            pg8::gemm_phase<EpiSwiglu>(lds, g, S, E); SEAM(pb + 8);
        }
        if (EN(10) && IN(pb + 9)) for (int rep = 0; rep < REPS(10); ++rep) {
            unsigned* tc = (unsigned*)(ws + WS_CTL) + CW_TAIL;
            int wfull = 0, whalf = 0;
            if (fusetail) {
                int pmf = -1, pmh = -1;
                { GOrder S; S.init(64, 4, G, bx, 1, nullptr); pg8::Unit u; if (S.next(0, u)) pmf = u.pm; }
                { GOrder S; S.init(8, 4, G, bx - (G - 64), 4, nullptr); S.P = 2; S.Kp = DFF / 2; pg8::Unit u; if (S.next(0, u)) pmh = u.pm; }
                for (int k = 0; k < ntail13; ++k) { GOrder S; S.init(T / 256, 2 * DFF / 256, G, k, 0, nullptr); S.i0 = nfull13; S.chunk = true; pg8::Unit u; if (S.next(0, u)) { wfull |= (u.pm == pmf) ? 1 : 0; whalf |= (u.pm == pmh) ? 1 : 0; } }
                wfull = __builtin_amdgcn_readfirstlane(wfull); whalf = __builtin_amdgcn_readfirstlane(whalf);
                if (bx < ntail13) {
                    Gemm g{U, (const bf16*)(ws + WS_W13) + (size_t)j * 2 * DFF * DM, DM, DM, DM}; GOrder S; S.init(T / 256, 2 * DFF / 256, G, bx, 0, nullptr); S.i0 = nfull13; S.imax = 1; S.chunk = true;
                    EpiSwiglu E{(bf16*)(ar + AR_HID), DFF};
                    pg8::gemm_phase<EpiSwiglu>(lds, g, S, E);
                    tail_signal(tc);
                }
            }
            const unsigned ttarget = (unsigned)ntail13 * (unsigned)(j + 1);
            {
                Gemm g{(const bf16*)(ar + AR_HID), (const bf16*)(ws + WS_W2) + (size_t)j * DM * DFF, DFF, DFF, DFF}; GOrder S; S.init(64, 4, G, bx, 1, nullptr);
                EpiResid E{(bf16*)(ws + WS_D), MOD + (size_t)(LE * 9) * 6144 + 5 * 1024};
                if (wfull) tail_wait(tc, ttarget);
                pg8::gemm_phase<EpiResid>(lds, g, S, E);
            }
            {
                Gemm g{(const bf16*)(ar + AR_HID), (const bf16*)(ws + WS_W2) + (size_t)j * DM * DFF, DFF, DFF, DFF / 2}; GOrder S; S.init(8, 4, G, fusetail ? bx - (G - 64) : bx, 4, nullptr); S.P = 2; S.Kp = DFF / 2;
                EpiResidPart E{(bf16*)(ws + WS_D), MOD + (size_t)(LE * 9) * 6144 + 5 * 1024, (float*)(ws + WS_PART)};
                if (whalf) tail_wait(tc, ttarget);
                pg8::gemm_phase<EpiResidPart>(lds, g, S, E);
            }
            if (rep == 0 && (fusetail ? (bx >= 64 && bx < G - 64) : bx >= 64)) moe_convert_queue(P, lds, j, 2);
            SEAM(pb + 9);
        }
        const bool lastl = (j == 1);
        if (EN(11) && IN(pb + 10)) for (int rep = 0; rep < REPS(11); ++rep) { norm_phase<false, false>(P, vcu, G, LO, 0, false, false, 1, true); SEAM(pb + 10); }
        const int nunq = (T / 256) * 12, nfullq = nunq / G, ntailq = nunq - nfullq * G;
        const bool fuseq = (G == 256) && (hi - lo > 1) && ntailq > 0;
        if (EN(12) && IN(pb + 11)) for (int rep = 0; rep < REPS(12); ++rep) {
            Gemm g{U, (const bf16*)(ws + WS_WQKV) + (size_t)j * 3 * DM * DM, DM, DM, DM}; GOrder S; S.init(T / 256, 12, G, bx, 0, nullptr); if (fuseq) { S.imax = nfullq; S.chunk = true; }
            EpiQKV E{ar, P.in[I_QG] + j * 64, P.in[I_KG] + j * 64};
            pg8::gemm_phase<EpiQKV>(lds, g, S, E); SEAM(pb + 11);
        }
        if (EN(13) && IN(pb + 12)) for (int rep = 0; rep < REPS(13); ++rep) {
            const float* rpbp = P.in[I_RPB] + (size_t)j * 16 * 465;
            if (fuseq) {
                unsigned* tq = (unsigned*)(ws + WS_CTL) + CW_TAILQ;
                if (bx < ntailq) {
                    Gemm g{U, (const bf16*)(ws + WS_WQKV) + (size_t)j * 3 * DM * DM, DM, DM, DM}; GOrder S; S.init(T / 256, 12, G, bx, 0, nullptr); S.i0 = nfullq; S.imax = 1; S.chunk = true;
                    EpiQKV E{ar, P.in[I_QG] + j * 64, P.in[I_KG] + j * 64};
                    pg8::gemm_phase<EpiQKV>(lds, g, S, E);
                    tail_signal(tq);
                }
                for (int k = 0; k < 4; ++k) {
                    if (k == 3) tail_wait(tq, (unsigned)ntailq * (unsigned)(j + 1));
                    attn_item(lds, ((vcu >> 5) << 7) | (((vcu >> 1) & 15) << 3) | (2 * k + (vcu & 1)), ar, rpbp);
                }
                if (!lastl && bx >= 128) attn_item(lds, 1024 + (bx - 128), ar, rpbp);
            } else {
                const int nit = lastl ? 1024 : 1152;
                for (int it = vcu; it < nit; it += G) attn_item(lds, it, ar, rpbp);
            }
            SEAM(pb + 12);
        }
        if (EN(14) && IN(pb + 13)) for (int rep = 0; rep < REPS(14); ++rep) {
            Gemm g{(const bf16*)(ar + AR_AO), (const bf16*)(ws + WS_WO) + (size_t)j * DM * DM, DM, DM, DM}; GOrder S; S.init(lastl ? 64 : 72, 4, G, bx, lastl ? 1 : 0, nullptr);
            EpiResid E{(bf16*)(ws + WS_D), MOD + (size_t)(LO * 9) * 6144 + 2 * 1024};
            pg8::gemm_phase<EpiResid>(lds, g, S, E);
            if (rep == 0 && !lastl && bx >= 32) moe_convert_queue(P, lds, j, 1);
            SEAM(pb + 13);
        }
        if (EN(15) && IN(pb + 14)) for (int rep = 0; rep < REPS(15); ++rep) { norm_phase<true, false>(P, vcu, G, LO, 1, false, lastl, 0, true); SEAM(pb + 14); }
        if (EN(16) && IN(pb + 15)) for (int rep = 0; rep < REPS(16); ++rep) { dispatch_phase(P, lds, vcu, G, lastl); if (rep == 0) moe_convert_queue(P, lds, j, 1 << 20); SEAM(pb + 15); }
        if (EN(17) && IN(pb + 16)) for (int rep = 0; rep < REPS(17); ++rep) {
            const int ntile = __builtin_amdgcn_readfirstlane(TILE[160]);
            Gemm g{(const bf16*)(ar + AR_UG), (const bf16*)(ws + WS_MW13), DM, DM, DM}; GOrder S; S.init(ntile, 2 * DFF / 256, G, bx, 2, TILE);
            EpiSwiglu E{(bf16*)(ar + AR_HM), DFF};
            pg8::gemm_phase<EpiSwiglu>(lds, g, S, E); SEAM(pb + 16);
        }
        if (EN(18) && IN(pb + 17)) for (int rep = 0; rep < REPS(18); ++rep) {
            const int ntile = __builtin_amdgcn_readfirstlane(TILE[160]);
            const int nun = 4 * ntile, Ffull = (nun / G) * G, tl = nun - Ffull;
            const bool split = (G == 256) && tl > 0 && tl <= 128 && Ffull > 0;
            {
                Gemm g{(const bf16*)(ar + AR_HM), (const bf16*)(ws + WS_MW2), DFF, DFF, DFF}; GOrder S; S.init(ntile, 4, G, bx, 2, TILE); if (split) S.imax = Ffull / G;
                EpiBf16 E{(bf16*)(ar + AR_Y32), DM};
                pg8::gemm_phase<EpiBf16>(lds, g, S, E);
            }
            if (split) {
                Gemm g{(const bf16*)(ar + AR_HM), (const bf16*)(ws + WS_MW2), DFF, DFF, DFF / 2}; GOrder S; S.init(ntile, 4, G, bx, 6, TILE); S.F = Ffull; S.tail = tl; S.Kp = DFF / 2;
                EpiMoeTail E{(bf16*)(ar + AR_Y32), (bf16*)(ws + WS_PART), (unsigned*)(ws + WS_CTL) + CW_YF + 1024 * j};
                pg8::gemm_phase<EpiMoeTail>(lds, g, S, E);
            }
            SEAM(pb + 17);
        }
    }
    if (EN(19) && IN(NPHASE - 1)) final_phase(P, vcu, G);
#undef IN
#undef SEAM
}

extern "C" void kernel_launch(void* const* d_in, const int* in_sizes, int n_in, void* d_out, int out_size, void* d_ws, size_t ws_size, hipStream_t stream) {
    static int grid = 0;
    if (grid == 0) {
        if (n_in != 31 || out_size != NBATCH * SEQ * DM || ws_size < WS_END) { fprintf(stderr, "kernel_launch: unexpected problem: n_in %d out %d ws %zu (need %zu)\n", n_in, out_size, ws_size, (size_t)WS_END); grid = -1; return; }
        int dev = 0, cus = 0;
        if (hipGetDevice(&dev) != hipSuccess || hipDeviceGetAttribute(&cus, hipDeviceAttributeMultiprocessorCount, dev) != hipSuccess) { grid = -1; return; }
        if (hipFuncSetAttribute((const void*)fwd_kernel, hipFuncAttributeMaxDynamicSharedMemorySize, LDS_BYTES) != hipSuccess) { fprintf(stderr, "kernel_launch: hipFuncSetAttribute failed\n"); grid = -1; return; }
        int per_cu = 0;
        if (hipOccupancyMaxActiveBlocksPerMultiprocessor(&per_cu, (const void*)fwd_kernel, 512, LDS_BYTES) != hipSuccess || per_cu < 1) { fprintf(stderr, "kernel_launch: occupancy query reports %d blocks per CU\n", per_cu); }
        (void)hipGetLastError();
        grid = cus;
    }
    if (grid < 0) return;
    (void)hipMemsetAsync((char*)d_ws + WS_CTL, 0, CTL_ZERO_BYTES, stream);
    Ptrs p{};
    for (int i = 0; i < 31; ++i) p.in[i] = (const float*)d_in[i];
    p.out = (float*)d_out; p.ws = (unsigned char*)d_ws;
#if MK_SPLIT
    for (int k = 0; k < NPHASE; ++k) { p.ph_lo = k; p.ph_hi = k + 1; hipLaunchKernelGGL(fwd_kernel, dim3(grid), dim3(512), LDS_BYTES, stream, p); }
#else
    p.ph_lo = 0; p.ph_hi = NPHASE;
    hipLaunchKernelGGL(fwd_kernel, dim3(grid), dim3(512), LDS_BYTES, stream, p);
#endif
}
```

```cpp
#include <hip/hip_runtime.h>
#include <cstdio>
#include <cstdint>

#define GAS __attribute__((address_space(1)))
#define LAS __attribute__((address_space(3)))
#define DI __device__ __forceinline__
typedef unsigned short bf16;
typedef short bf16x8 __attribute__((ext_vector_type(8)));
typedef short s16x4 __attribute__((ext_vector_type(4)));
typedef short v4i16_t __attribute__((ext_vector_type(4)));
typedef float f32x2 __attribute__((ext_vector_type(2)));
typedef float f32x4 __attribute__((ext_vector_type(4)));
typedef float f32x16 __attribute__((ext_vector_type(16)));
typedef unsigned u32x2 __attribute__((ext_vector_type(2)));
typedef unsigned u32x4 __attribute__((ext_vector_type(4)));
typedef __bf16 bf16x2_t __attribute__((ext_vector_type(2)));

#ifndef MK_SPLIT
#define MK_SPLIT 0
#endif

constexpr int DM = 1024, NBATCH = 8, SEQ = 2048, CTXL = 256, TB = SEQ + CTXL  , T = NBATCH * TB  ;
constexpr int HGW = 512, EVIN = 3584, DFF = 2816, NEXP = 8, NHEAD = 16;
constexpr int MAXSLOT = 38912;
constexpr float EPS = 1e-6f;

DI unsigned cvtpk(float lo, float hi) { f32x2 v = {lo, hi}; bf16x2_t b = __builtin_convertvector(v, bf16x2_t); return __builtin_bit_cast(unsigned, b); }
DI float bf2f(unsigned short b) { return __uint_as_float(((unsigned)b) << 16); }
DI float bflo(unsigned w) { return __uint_as_float(w << 16); }
DI float bfhi(unsigned w) { return __uint_as_float(w & 0xffff0000u); }
DI float sigmoid_(float x) { return __builtin_amdgcn_rcpf(1.f + __expf(-x)); }
DI float silu_(float x) { return x * sigmoid_(x); }
DI float logsigmoid_(float x) { return fminf(x, 0.f) - log1pf(__expf(-fabsf(x))); }
DI float gelu_tanh_(float x) { const float u = 0.7978845608028654f * (x + 0.044715f * x * x * x); const float t = 1.f - 2.f * __builtin_amdgcn_rcpf(1.f + __expf(2.f * u)); return 0.5f * x * (1.f + t); }
template <int CTRL, int RM> DI float dpp_mov(float v) { return __builtin_bit_cast(float, __builtin_amdgcn_update_dpp(0, __builtin_bit_cast(int, v), CTRL, RM, 0xf, false)); }
DI float wave_sum(float v) {
    v += dpp_mov<0xB1, 0xf>(v); v += dpp_mov<0x4E, 0xf>(v); v += dpp_mov<0x141, 0xf>(v); v += dpp_mov<0x140, 0xf>(v);
    v += dpp_mov<0x142, 0xa>(v); v += dpp_mov<0x143, 0xc>(v);
    return __builtin_bit_cast(float, __builtin_amdgcn_readlane(__builtin_bit_cast(int, v), 63));
}
constexpr int TIDTAB_OFF = 131072 + 1024;
DI int hw_wave_slot() { return (int)(__builtin_amdgcn_s_getreg(0x2804) & 63u); }
DI float shfl_xor_l(float v, int lane, int mask) { return __builtin_bit_cast(float, __builtin_amdgcn_ds_bpermute((lane ^ mask) << 2, __builtin_bit_cast(int, v))); }
DI int shfl_xor_l(int v, int lane, int mask) { return __builtin_amdgcn_ds_bpermute((lane ^ mask) << 2, v); }
DI int opaque_tid() {
    const int wv = *(const volatile LAS int*)(size_t)(TIDTAB_OFF + 4 * hw_wave_slot());
    int lane; asm volatile("v_mbcnt_lo_u32_b32 %0, -1, 0\n\tv_mbcnt_hi_u32_b32 %0, -1, %0" : "=&v"(lane));
    return (__builtin_amdgcn_readfirstlane(wv) << 6) | lane; }
DI s16x4 vtr(const LAS unsigned char* p) { return __builtin_bit_cast(s16x4, __builtin_amdgcn_ds_read_tr16_b64_v4i16((LAS v4i16_t*)p)); }
DI bf16x8 cat8(s16x4 lo, s16x4 hi) { return __builtin_shufflevector(lo, hi, 0, 1, 2, 3, 4, 5, 6, 7); }
DI int crow(int reg, int h) { return (reg & 3) + 8 * (reg >> 2) + 4 * h; }
#define MFMA32(a, b, c) __builtin_amdgcn_mfma_f32_32x32x16_bf16((a), (b), (c), 0, 0, 0)
DI bf16x8 pack8(const f32x16& x, int s) {
    u32x4 p; p.x = cvtpk(x[8 * s], x[8 * s + 1]); p.y = cvtpk(x[8 * s + 2], x[8 * s + 3]); p.z = cvtpk(x[8 * s + 4], x[8 * s + 5]); p.w = cvtpk(x[8 * s + 6], x[8 * s + 7]);
    return __builtin_bit_cast(bf16x8, p);
}

namespace pg8 {
constexpr int BM = 256, BK = 64, HALF = 128, HTB = HALF * BK * 2, STAGE_BYTES = 8 * HTB, NXCD = 8, WGM = 8;
__host__ __device__ __forceinline__ int lds_byte(int r, int c) { const int st = (r >> 4) * 2 + (c >> 5), rr = r & 15, cc = c & 31, ob = rr * 64 + cc * 2; return st * 1024 + (ob ^ (((ob >> 9) & 1) << 5)); }
__host__ __device__ __forceinline__ void stage_rc(int b, int& R, int& C) { const int st = b / 1024, sb = b % 1024, swz = sb ^ (((sb >> 9) & 1) << 5); R = (st >> 1) * 16 + swz / 64; C = (st & 1) * 32 + (swz % 64) / 2; }
__host__ __device__ __forceinline__ int perm32(int rho) { const int n = rho >> 4, i = rho & 15; return 8 * (i >> 2) + 4 * n + (i & 3); }

struct Unit { int pm, pn, pb, ka, kb, part, tix; };
struct Gemm { const bf16* A; const bf16* Bt; int lda, K, kloop; };

struct GOrder {
    int nM, nN, nwg, G, c, mode, P, Kp, imax, F, tail, i0; bool chunk; const int* tile_e;
    DI void init(int nM_, int nN_, int G_, int c_, int mode_, const int* te) { nM = nM_; nN = nN_; nwg = nM * nN; G = G_; c = c_; mode = mode_; tile_e = te; P = 1; Kp = 0; imax = 1 << 30; F = 0; tail = 0; i0 = 0; chunk = false; }
    DI bool next(int i, Unit& u) const {
        if (mode == 4) { if (i > 0 || c < 0 || c >= 8 * nN * P) return false; const int un = c / P, p = c - un * P; u.pm = 9 * (un / nN); u.pn = un % nN; u.pb = u.pn; u.ka = p * Kp; u.kb = p * Kp; u.part = p; u.tix = 0; return true; }
        if (i >= imax) return false;
        long L = (long)(i + i0) * G + c; if (L >= nwg) return false;
        int part = 0, tix = 0;
        if (mode == 6) {
            if (i > 0 || c >= 2 * tail) return false;
            tix = c >> 1; part = c & 1; L = F + tix; }
        const int xcd = (int)L % NXCD, off = (int)L / NXCD;
        int idx, nMx, pm0;
        if (chunk) { idx = off; nMx = nM / NXCD; pm0 = xcd * nMx; }
        else { const int q = nwg / NXCD, r = nwg % NXCD; idx = (xcd < r ? xcd * (q + 1) : r * (q + 1) + (xcd - r) * q) + off; nMx = nM; pm0 = 0; }
        const int nig = WGM * nN, gid = idx / nig, fm = gid * WGM, gsz = (nMx - fm) < WGM ? (nMx - fm) : WGM, rem = idx - gid * nig;
        const int pn = rem / gsz, pm = pm0 + fm + (rem - pn * gsz);
        u.pm = pm; u.pn = pn; u.pb = pn; u.ka = 0; u.kb = 0; u.part = part; u.tix = tix;
        if (mode == 1) u.pm = pm + pm / 8 + 1;
        else if (mode == 2) u.pb = __builtin_amdgcn_readfirstlane(tile_e[pm]) * nN + pn;
        else if (mode == 6) { u.pb = __builtin_amdgcn_readfirstlane(tile_e[pm]) * nN + pn; u.ka = part * Kp; u.kb = part * Kp; }
        else if (mode == 3) u.ka = 256 * ((pn & 3) >> 1);
        return true;
    }
};

template <class Epi>
DI void gemm_phase(LAS unsigned char* lds, const Gemm g, const GOrder& S, const Epi& E) {
    const int tid = opaque_tid(), wid = __builtin_amdgcn_readfirstlane(tid >> 6), lane = tid & 63, wr = wid >> 2, wc = wid & 3, fr = lane & 15, fq = lane >> 4;
    int K = g.K, lda = g.lda, kloop = g.kloop; asm volatile("" : "+s"(K), "+s"(lda), "+s"(kloop));
    const int nt = kloop / BK;
    unsigned voffA[2], voffB[2];
#pragma unroll
    for (int i = 0; i < 2; ++i) { int R, C; stage_rc(tid * 16 + i * 8192, R, C); const int Rb = Epi::PERM ? ((R & ~31) + perm32(R & 31)) : R;
        voffA[i] = (unsigned)(R * lda + C) * 2u; voffB[i] = (unsigned)(Rb * K + C) * 2u; }
    const size_t kstep = (size_t)(BK * 2);
    const size_t hstepA = (size_t)HALF * lda * 2, hstepB = (size_t)HALF * K * 2;
    const size_t tstepA = 2 * hstepA, tstepB = 2 * hstepB;
    const unsigned ldsw = (unsigned)wid * 1024u;
    const int aoff = lds_byte(wr * 64 + fr, fq * 8), boff = lds_byte(wc * 32 + fr, fq * 8);
#define PG8_SA(b, h) (((b) * 2 + (h)) * HTB)
#define PG8_SB(b, h) ((4 + (b) * 2 + (h)) * HTB)
#define PG8_STAGE(bufoff, gbase, voff) do { _Pragma("unroll") for (int _i = 0; _i < 2; ++_i) \
        __builtin_amdgcn_global_load_lds((const unsigned*)((const char*)(gbase) + (voff)[_i]), (LAS unsigned*)(lds + (bufoff) + ldsw + _i * 8192), 16, 0, 0); } while (0)
#define PG8_LDA(dst, b, h) do { _Pragma("unroll") for (int m = 0; m < 4; ++m) _Pragma("unroll") for (int k = 0; k < 2; ++k) dst[m][k] = *(const LAS bf16x8*)(lds + PG8_SA(b, h) + aoff + m * 2048 + k * 1024); } while (0)
#define PG8_LDB(dst, b, h) do { _Pragma("unroll") for (int n = 0; n < 2; ++n) _Pragma("unroll") for (int k = 0; k < 2; ++k) dst[n][k] = *(const LAS bf16x8*)(lds + PG8_SB(b, h) + boff + n * 2048 + k * 1024); } while (0)
#define PG8_MMA(ai, bj, At, Bt) do { __builtin_amdgcn_s_setprio(1); _Pragma("unroll") for (int m = 0; m < 4; ++m) _Pragma("unroll") for (int n = 0; n < 2; ++n) _Pragma("unroll") for (int k = 0; k < 2; ++k) \
        acc[ai][bj][m][n] = __builtin_amdgcn_mfma_f32_16x16x32_bf16(Bt[n][k], At[m][k], acc[ai][bj][m][n], 0, 0, 0); __builtin_amdgcn_s_setprio(0); } while (0)
#define PG8_WAIT_V(n) asm volatile("s_waitcnt vmcnt(" #n ")" ::: "memory")
#define PG8_WAIT_L(n) asm volatile("s_waitcnt lgkmcnt(" #n ")" ::: "memory")
#define PG8_BAR __builtin_amdgcn_s_barrier()
#define PG8_SCHED __builtin_amdgcn_sched_barrier(0)
    Unit cur, nxt; int ui = 0;
    if (!S.next(0, cur)) return;
    f32x4 acc[2][2][4][2];
#pragma unroll
    for (int a = 0; a < 2; ++a)
#pragma unroll
        for (int b = 0; b < 2; ++b)
#pragma unroll
            for (int m = 0; m < 4; ++m)
#pragma unroll
                for (int n = 0; n < 2; ++n) acc[a][b][m][n] = (f32x4){0.f, 0.f, 0.f, 0.f};
    bf16x8 At[4][2], B0[2][2], B1[2][2];
    const char* cA = (const char*)g.A + (size_t)cur.pm * tstepA + (size_t)cur.ka * 2; const char* cB = (const char*)g.Bt + (size_t)cur.pb * tstepB + (size_t)cur.kb * 2;
    PG8_STAGE(PG8_SB(0, 0), cB, voffB); PG8_STAGE(PG8_SB(0, 1), cB + hstepB, voffB); PG8_STAGE(PG8_SA(0, 0), cA, voffA); PG8_STAGE(PG8_SA(0, 1), cA + hstepA, voffA);
    if (wr == 1) PG8_BAR;
    PG8_WAIT_V(2); PG8_BAR;
    PG8_STAGE(PG8_SB(1, 0), cB + kstep, voffB); PG8_STAGE(PG8_SA(1, 0), cA + kstep, voffA); PG8_STAGE(PG8_SB(1, 1), cB + hstepB + kstep, voffB);
    PG8_WAIT_V(6); PG8_BAR;
    for (;;) {
        const bool has_next = S.next(ui + 1, nxt);
        const char* nA = has_next ? (const char*)g.A + (size_t)nxt.pm * tstepA + (size_t)nxt.ka * 2 : cA; const char* nB = has_next ? (const char*)g.Bt + (size_t)nxt.pb * tstepB + (size_t)nxt.kb * 2 : cB;
        for (int t = 0; t < nt; t += 2) {
            const bool last = (t == nt - 2);
            const char* a1 = cA + (size_t)(t + 1) * kstep;
            const char* a2 = last ? nA : cA + (size_t)(t + 2) * kstep; const char* b2 = last ? nB : cB + (size_t)(t + 2) * kstep;
            const char* a3 = a2 + kstep; const char* b3 = b2 + kstep;
            PG8_LDB(B0, 0, 0); PG8_LDB(B1, 0, 1); PG8_SCHED; PG8_LDA(At, 0, 0); PG8_STAGE(PG8_SA(1, 1), a1 + hstepA, voffA);
            PG8_WAIT_V(8); PG8_WAIT_L(0); PG8_BAR; PG8_MMA(0, 0, At, B0); PG8_MMA(0, 1, At, B1); PG8_BAR; PG8_SCHED;
            PG8_LDA(At, 0, 1); PG8_STAGE(PG8_SB(0, 0), b2, voffB); PG8_STAGE(PG8_SB(0, 1), b2 + hstepB, voffB); PG8_STAGE(PG8_SA(0, 0), a2, voffA);
            PG8_WAIT_V(8); PG8_WAIT_L(0); PG8_BAR; PG8_MMA(1, 0, At, B0); PG8_MMA(1, 1, At, B1); PG8_BAR; PG8_SCHED;
            PG8_LDB(B0, 1, 0); PG8_LDB(B1, 1, 1); PG8_SCHED; PG8_LDA(At, 1, 0); PG8_STAGE(PG8_SA(0, 1), a2 + hstepA, voffA);
            PG8_WAIT_V(8); PG8_WAIT_L(0); PG8_BAR; PG8_MMA(0, 0, At, B0); PG8_MMA(0, 1, At, B1); PG8_BAR; PG8_SCHED;
            PG8_LDA(At, 1, 1); PG8_STAGE(PG8_SB(1, 0), b3, voffB); PG8_STAGE(PG8_SB(1, 1), b3 + hstepB, voffB); PG8_STAGE(PG8_SA(1, 0), a3, voffA);
            PG8_WAIT_V(8); PG8_WAIT_L(0); PG8_BAR; PG8_MMA(1, 0, At, B0); PG8_MMA(1, 1, At, B1); PG8_BAR; PG8_SCHED;
        }
        if (wr == 0) PG8_BAR;
        E(acc, cur, wr, wc, fr, fq);
        if (!has_next) break;
#pragma unroll
        for (int a = 0; a < 2; ++a)
#pragma unroll
            for (int b = 0; b < 2; ++b)
#pragma unroll
                for (int m = 0; m < 4; ++m)
#pragma unroll
                    for (int n = 0; n < 2; ++n) acc[a][b][m][n] = (f32x4){0.f, 0.f, 0.f, 0.f};
        cur = nxt; cA = nA; cB = nB; ++ui;
        if (wr == 1) PG8_BAR;
    }
    PG8_WAIT_V(0);
    PG8_BAR;
#undef PG8_SA
#undef PG8_SB
#undef PG8_STAGE
#undef PG8_LDA
#undef PG8_LDB
#undef PG8_MMA
#undef PG8_WAIT_V
#undef PG8_WAIT_L
#undef PG8_BAR
#undef PG8_SCHED
}
}
using pg8::Unit;
using pg8::Gemm;
using pg8::GOrder;

#define XB_TMO      128
#define XB_XCNT(j)  (256  + 64 * (j))
#define XB_XSUB(j)  (1280 + 64 * (j))
#define XB_XGEN(j)  (2304 + 64 * (j))
#define XB_TOP      3328
#define XB_TOPGEN   3392
#define XCD_BAR_WORDS 3456
#define XB_SPIN_CAP (1u << 18)
__device__ __forceinline__ unsigned xb_ld(unsigned* p)              { return __hip_atomic_load(p, __ATOMIC_RELAXED, __HIP_MEMORY_SCOPE_AGENT); }
__device__ __forceinline__ unsigned xb_add(unsigned* p, unsigned v) { return __hip_atomic_fetch_add(p, v, __ATOMIC_RELAXED, __HIP_MEMORY_SCOPE_AGENT); }
__device__ __forceinline__ unsigned xb_xcc_id() { return (unsigned)__builtin_amdgcn_s_getreg((3 << 11) | 20) & 0xFu; }
#define XB_SPIN(cond, bar) do { unsigned _sp = 0; while (cond) { __builtin_amdgcn_s_sleep(1); \
    if ((++_sp & 255u) == 0u) { if (xb_ld(&(bar)[XB_TMO])) break; if (_sp > XB_SPIN_CAP) { atomicAdd(&(bar)[XB_TMO], 1u); break; } } } } while (0)
struct XcdBarrier { unsigned* bar; unsigned x; volatile LAS unsigned* st; };
__device__ __forceinline__ XcdBarrier xcd_barrier_post(unsigned* bar, volatile LAS unsigned* st) {
    XcdBarrier b; b.bar = bar; b.x = xb_xcc_id(); b.st = st;
    if (opaque_tid() == 0) (void)xb_add(&bar[XB_XCNT(b.x)], 1u);
    return b;
}
__device__ __forceinline__ void xcd_barrier_complete(unsigned* bar, unsigned x, unsigned& nloc, unsigned& nx) {
    const unsigned G = gridDim.x * gridDim.y * gridDim.z;
    unsigned sum, cnt, mine, sp = 0u;
    for (;;) {
        sum = 0u; cnt = 0u; mine = 0u;
#pragma unroll
        for (unsigned j = 0; j < 16; ++j) { const unsigned c = xb_ld(&bar[XB_XCNT(j)]); sum += c; cnt += (c > 0u) ? 1u : 0u; mine = (j == x) ? c : mine; }
        if (sum == G) break;
        __builtin_amdgcn_s_sleep(1);
        if ((++sp & 255u) == 0u) { if (xb_ld(&bar[XB_TMO])) break; if (sp > XB_SPIN_CAP) { atomicAdd(&bar[XB_TMO], 1u); break; } }
    }
    nloc = mine > 0u ? mine : 1u; nx = cnt > 0u ? cnt : 1u;
}
__device__ __forceinline__ void xcd_barrier(const XcdBarrier& b) {
    asm volatile("s_waitcnt vmcnt(0)" ::: "memory");
    __syncthreads();
    if (opaque_tid() == 0) {
        unsigned* bar = b.bar;
        __builtin_amdgcn_s_waitcnt(0);
        unsigned nloc = b.st[0], nx = b.st[1];
        if (nloc == 0u) { xcd_barrier_complete(bar, b.x, nloc, nx); b.st[0] = nloc; b.st[1] = nx; }
        const unsigned old = xb_add(&bar[XB_XSUB(b.x)], 1u);
        const unsigned gen = old / nloc;
        if (old + 1u == (gen + 1u) * nloc) {
            __builtin_amdgcn_fence(__ATOMIC_RELEASE, "agent");
            asm volatile("s_waitcnt vmcnt(0)" ::: "memory");
            const unsigned og = xb_add(&bar[XB_TOP], 1u);
            const unsigned tg = og / nx;
            if (og + 1u == (tg + 1u) * nx) xb_add(&bar[XB_TOPGEN], 1u);
            else XB_SPIN(xb_ld(&bar[XB_TOPGEN]) == tg, bar);
            __builtin_amdgcn_fence(__ATOMIC_ACQUIRE, "agent");
            xb_add(&bar[XB_XGEN(b.x)], 1u);
            asm volatile("s_waitcnt vmcnt(0)" ::: "memory");
        } else {
            XB_SPIN(xb_ld(&bar[XB_XGEN(b.x)]) == gen, bar);
            __builtin_amdgcn_fence(__ATOMIC_ACQUIRE, "agent");
            asm volatile("s_waitcnt vmcnt(0)" ::: "memory");
        }
    }
    __syncthreads();
}

__device__ __forceinline__ void sub_barrier(unsigned* cnt, unsigned target) {
    asm volatile("s_waitcnt vmcnt(0)" ::: "memory");
    __syncthreads();
    if (opaque_tid() == 0) {
        __builtin_amdgcn_fence(__ATOMIC_RELEASE, "agent");
        asm volatile("s_waitcnt vmcnt(0)" ::: "memory");
        (void)xb_add(cnt, 1u);
        unsigned sp = 0u;
        while (xb_ld(cnt) < target) { __builtin_amdgcn_s_sleep(1); if (++sp > (1u << 22)) break; }
        __builtin_amdgcn_fence(__ATOMIC_ACQUIRE, "agent");
        asm volatile("s_waitcnt vmcnt(0)" ::: "memory");
    }
    __syncthreads();
}

#define XL_SUB(x) (64 * (x))
#define XL_GEN(x) (1024 + 64 * (x))
__device__ __forceinline__ void xcc_local_barrier(unsigned* lb, unsigned x, unsigned nloc) {
    asm volatile("s_waitcnt vmcnt(0)" ::: "memory");
    __syncthreads();
    if (opaque_tid() == 0) {
        const unsigned old = xb_add(&lb[XL_SUB(x)], 1u);
        const unsigned gen = old / nloc;
        if (old + 1u == (gen + 1u) * nloc) {
            __builtin_amdgcn_fence(__ATOMIC_RELEASE, "agent");
            asm volatile("s_waitcnt vmcnt(0)" ::: "memory");
            __builtin_amdgcn_fence(__ATOMIC_ACQUIRE, "agent");
            xb_add(&lb[XL_GEN(x)], 1u);
            asm volatile("s_waitcnt vmcnt(0)" ::: "memory");
        } else {
            unsigned sp = 0u;
            while (xb_ld(&lb[XL_GEN(x)]) == gen) { __builtin_amdgcn_s_sleep(1); if (++sp > (1u << 22)) break; }
            __builtin_amdgcn_fence(__ATOMIC_ACQUIRE, "agent");
            asm volatile("s_waitcnt vmcnt(0)" ::: "memory");
        }
    }
    __syncthreads();
}
__device__ __forceinline__ void tail_signal(unsigned* cnt) {
    asm volatile("s_waitcnt vmcnt(0)" ::: "memory");
    __syncthreads();
    if (opaque_tid() == 0) { __builtin_amdgcn_fence(__ATOMIC_RELEASE, "agent"); asm volatile("s_waitcnt vmcnt(0)" ::: "memory"); (void)xb_add(cnt, 1u); }
}
__device__ __forceinline__ void tail_wait(unsigned* cnt, unsigned target) {
    __syncthreads();
    if (opaque_tid() == 0) {
        unsigned sp = 0u;
        while (xb_ld(cnt) < target) { __builtin_amdgcn_s_sleep(1); if (++sp > (1u << 22)) break; }
        __builtin_amdgcn_fence(__ATOMIC_ACQUIRE, "agent");
        asm volatile("s_waitcnt vmcnt(0)" ::: "memory");
    }
    __syncthreads();
}

constexpr size_t MiB = 1u << 20;
constexpr size_t WS_CTL = 0, CTL_ZERO_BYTES = 1 * MiB;
constexpr int CW_BAR = 4096;
constexpr int CW_TILE = 65536;
constexpr size_t WS_MOD = 1 * MiB;
constexpr size_t WS_LBT = 2 * MiB;
constexpr size_t WS_WG = 3 * MiB;
constexpr size_t WS_TOPE = 5 * MiB, WS_TOPW = WS_TOPE + 128 * 1024, WS_SLOT = WS_TOPW + 256 * 1024, WS_WCNT = WS_SLOT + 256 * 1024;
constexpr size_t WS_WIN = 8 * MiB, WS_WOUT = 22 * MiB, WS_W13 = 26 * MiB, WS_W2 = 48 * MiB, WS_WQKV = 59 * MiB, WS_WO = 71 * MiB, WS_MW13 = 75 * MiB, WS_MW2 = 163 * MiB;
constexpr size_t WS_R = 207 * MiB, WS_U = 279 * MiB, WS_AR = 315 * MiB, WS_PART = (315 + 437) * MiB, WS_D = WS_PART + 24 * MiB, WS_END = WS_D + 36 * MiB;
constexpr size_t AR_QH = 0, AR_KKF = 18 * MiB, AR_KKB = 36 * MiB, AR_VV = 54 * MiB, AR_GS = 72 * MiB, AR_YG = 90 * MiB, AR_LFF = 108 * MiB, AR_LFB = 144 * MiB, AR_XR = 180 * MiB,
                 AR_XC = 216 * MiB, AR_LAF = 234 * MiB, AR_LAB = 252 * MiB, AR_BBF = 270 * MiB, AR_BBB = 288 * MiB, AR_OF = 306 * MiB, AR_OB = 324 * MiB, AR_HF = 342 * MiB, AR_HB = 360 * MiB,
                 AR_MIX = 378 * MiB, AR_HID = 0;
constexpr size_t AR_QB = 0, AR_KB = 36 * MiB, AR_VB = 72 * MiB, AR_AO = 108 * MiB, AR_UG = 0, AR_HM = 76 * MiB, AR_Y32 = 285 * MiB;
static_assert((size_t)MAXSLOT * 1024 * 2 <= 76 * MiB && (size_t)MAXSLOT * DFF * 2 <= 209 * MiB && (size_t)MAXSLOT * 1024 * 4 <= 152 * MiB, "arena");
static_assert((size_t)T * DFF * 2 <= 108 * MiB, "HID");

constexpr int RING_BYTES = 131072, MISC_OFF = RING_BYTES + 320, LDS_BYTES = 147456;

struct EpiResid {
    static constexpr bool PERM = true;
    bf16* Dd; const float* gate;
    DI void operator()(const f32x4 (&acc)[2][2][4][2], const Unit& u, int wr, int wc, int fr, int fq) const {
        const int b = u.pm / 9, mrow = (u.pm - b * 9 == 0) ? 8 : b;
        const int row0 = u.pm * 256 + wr * 64 + fr, col0 = u.pn * 256 + wc * 32 + 8 * fq;
        f32x4 gv[2][2];
#pragma unroll
        for (int bj = 0; bj < 2; ++bj)
#pragma unroll
            for (int n = 0; n < 2; ++n) gv[bj][n] = *(const f32x4*)(gate + (size_t)mrow * 6144 + col0 + bj * 128 + n * 4);
#pragma unroll
        for (int ai = 0; ai < 2; ++ai)
#pragma unroll
            for (int m = 0; m < 4; ++m)
#pragma unroll
                for (int bj = 0; bj < 2; ++bj) { const f32x4 a0 = gv[bj][0] * acc[ai][bj][m][0], a1 = gv[bj][1] * acc[ai][bj][m][1];
                    u32x4 w; w.x = cvtpk(a0[0], a0[1]); w.y = cvtpk(a0[2], a0[3]); w.z = cvtpk(a1[0], a1[1]); w.w = cvtpk(a1[2], a1[3]);
                    *(u32x4*)(Dd + (size_t)(row0 + ai * 128 + m * 16) * DM + col0 + bj * 128) = w; }
    }
};
struct EpiResidPart {
    static constexpr bool PERM = true;
    bf16* Dd; const float* gate; float* part;
    DI void operator()(const f32x4 (&acc)[2][2][4][2], const Unit& u, int wr, int wc, int fr, int fq) const {
        const int b = u.pm / 9;
        const int row0 = wr * 64 + fr, col0 = u.pn * 256 + wc * 32 + 8 * fq;
#pragma unroll
        for (int bj = 0; bj < 2; ++bj) {
            const f32x4 g0 = *(const f32x4*)(gate + (size_t)8 * 6144 + col0 + bj * 128), g1 = *(const f32x4*)(gate + (size_t)8 * 6144 + col0 + bj * 128 + 4);
            if (u.part == 0) {
#pragma unroll
                for (int ai = 0; ai < 2; ++ai)
#pragma unroll
                    for (int m = 0; m < 4; ++m) { const f32x4 a0 = g0 * acc[ai][bj][m][0], a1 = g1 * acc[ai][bj][m][1];
                        u32x4 w; w.x = cvtpk(a0[0], a0[1]); w.y = cvtpk(a0[2], a0[3]); w.z = cvtpk(a1[0], a1[1]); w.w = cvtpk(a1[2], a1[3]);
                        *(u32x4*)(Dd + (size_t)(u.pm * 256 + row0 + ai * 128 + m * 16) * DM + col0 + bj * 128) = w; }
            } else {
                float* base = part + (size_t)(u.part - 1) * 2048 * DM + (size_t)(b * 256 + row0) * DM + col0 + bj * 128;
#pragma unroll
                for (int ai = 0; ai < 2; ++ai)
#pragma unroll
                    for (int m = 0; m < 4; ++m) { float* rowp = base + (size_t)(ai * 128 + m * 16) * DM;
                        *(f32x4*)rowp = g0 * acc[ai][bj][m][0]; *(f32x4*)(rowp + 4) = g1 * acc[ai][bj][m][1]; }
            }
        }
    }
};
struct EpiF32 {
    static constexpr bool PERM = false;
    float* C; int ldc;
    DI void operator()(const f32x4 (&acc)[2][2][4][2], const Unit& u, int wr, int wc, int fr, int fq) const {
        const int row0 = u.pm * 256 + wr * 64 + fr, col0 = u.pn * 256 + wc * 32 + 4 * fq;
#pragma unroll
        for (int ai = 0; ai < 2; ++ai)
#pragma unroll
            for (int m = 0; m < 4; ++m) { float* rowp = C + (size_t)(row0 + ai * 128 + m * 16) * ldc + col0;
#pragma unroll
                for (int bj = 0; bj < 2; ++bj)
#pragma unroll
                    for (int n = 0; n < 2; ++n) *(f32x4*)(rowp + bj * 128 + n * 16) = acc[ai][bj][m][n]; }
    }
};
struct EpiBf16 {
    static constexpr bool PERM = true;
    bf16* C; int ldc;
    DI void operator()(const f32x4 (&acc)[2][2][4][2], const Unit& u, int wr, int wc, int fr, int fq) const {
        const int row0 = u.pm * 256 + wr * 64 + fr, col0 = u.pn * 256 + wc * 32 + 8 * fq;
#pragma unroll
        for (int ai = 0; ai < 2; ++ai)
#pragma unroll
            for (int m = 0; m < 4; ++m)
#pragma unroll
                for (int bj = 0; bj < 2; ++bj) { const f32x4 a0 = acc[ai][bj][m][0], a1 = acc[ai][bj][m][1];
                    u32x4 w; w.x = cvtpk(a0[0], a0[1]); w.y = cvtpk(a0[2], a0[3]); w.z = cvtpk(a1[0], a1[1]); w.w = cvtpk(a1[2], a1[3]);
                    *(u32x4*)(C + (size_t)(row0 + ai * 128 + m * 16) * ldc + col0 + bj * 128) = w; }
    }
};
constexpr int CW_YF = 72064;
struct EpiMoeTail {
    static constexpr bool PERM = true;
    bf16* C; bf16* Y2; unsigned* flag;
    DI void operator()(const f32x4 (&acc)[2][2][4][2], const Unit& u, int wr, int wc, int fr, int fq) const {
        const int row0 = wr * 64 + fr, col0 = wc * 32 + 8 * fq;
        bf16* base = u.part == 0 ? C + (size_t)(u.pm * 256) * DM + u.pn * 256 : Y2 + (size_t)u.tix * 65536;
        const int ld = u.part == 0 ? DM : 256;
#pragma unroll
        for (int ai = 0; ai < 2; ++ai)
#pragma unroll
            for (int m = 0; m < 4; ++m)
#pragma unroll
                for (int bj = 0; bj < 2; ++bj) { const f32x4 a0 = acc[ai][bj][m][0], a1 = acc[ai][bj][m][1];
                    u32x4 w; w.x = cvtpk(a0[0], a0[1]); w.y = cvtpk(a0[2], a0[3]); w.z = cvtpk(a1[0], a1[1]); w.w = cvtpk(a1[2], a1[3]);
                    *(u32x4*)(base + (size_t)(row0 + ai * 128 + m * 16) * ld + col0 + bj * 128) = w; }
        if (u.part == 1 && wr == 0 && wc == 0 && fr == 0 && fq == 0) { const unsigned fv = (unsigned)__builtin_amdgcn_readfirstlane(u.tix) + 1u; __hip_atomic_store(flag + u.pm * 4 + u.pn, fv, __ATOMIC_RELAXED, __HIP_MEMORY_SCOPE_AGENT); }
    }
};
struct EpiSwiglu {
    static constexpr bool PERM = true;
    bf16* H; int ldc;
    DI void operator()(const f32x4 (&acc)[2][2][4][2], const Unit& u, int wr, int wc, int fr, int fq) const {
        const int row0 = u.pm * 256 + wr * 64 + fr, col0 = u.pn * 128 + wc * 32 + 8 * fq;
#pragma unroll
        for (int ai = 0; ai < 2; ++ai)
#pragma unroll
            for (int m = 0; m < 4; ++m) {
                const f32x4 a0 = acc[ai][0][m][0], a1 = acc[ai][0][m][1], g0 = acc[ai][1][m][0], g1 = acc[ai][1][m][1];
                u32x4 w;
                w.x = cvtpk(silu_(a0[0]) * g0[0], silu_(a0[1]) * g0[1]); w.y = cvtpk(silu_(a0[2]) * g0[2], silu_(a0[3]) * g0[3]);
                w.z = cvtpk(silu_(a1[0]) * g1[0], silu_(a1[1]) * g1[1]); w.w = cvtpk(silu_(a1[2]) * g1[2], silu_(a1[3]) * g1[3]);
                *(u32x4*)(H + (size_t)(row0 + ai * 128 + m * 16) * ldc + col0) = w; }
    }
};
struct EpiEvenIn {
    static constexpr bool PERM = true;
    unsigned char* ar; const float* lbt;
    DI void operator()(const f32x4 (&acc)[2][2][4][2], const Unit& u, int wr, int wc, int fr, int fq) const {
        const int sidx = u.pn >> 1;
        const int row0 = u.pm * 256 + wr * 64 + fr, cs0 = (u.pn & 1) * 256 + wc * 32 + 8 * fq;
        if (sidx == 1 || sidx == 2) {
            const int d = sidx - 1;
            bf16* KK = (bf16*)(ar + (d ? AR_KKB : AR_KKF)); bf16* LF = (bf16*)(ar + (d ? AR_LFB : AR_LFF));
#pragma unroll
            for (int bj = 0; bj < 2; ++bj) {
                const int cs = cs0 + bj * 128;
#pragma unroll
                for (int n = 0; n < 2; ++n) {
                    const f32x4 oml = *(const f32x4*)(lbt + (d * 3 + 0) * 512 + cs + 4 * n), lbm = *(const f32x4*)(lbt + (d * 3 + 1) * 512 + cs + 4 * n);
#pragma unroll
                    for (int ai = 0; ai < 2; ++ai)
#pragma unroll
                        for (int m = 0; m < 4; ++m) {
                            const size_t o = (size_t)(row0 + ai * 128 + m * 16) * HGW + cs + 4 * n;
                            float kk[4]; f32x4 lf;
#pragma unroll
                            for (int e = 0; e < 4; ++e) { const float z = __builtin_amdgcn_fmed3f(acc[ai][bj][m][n][e], -80.f, 80.f);
                                const float ez = __expf(-z), sg = __builtin_amdgcn_rcpf(1.f + ez);
                                kk[e] = oml[e] * (ez * sg);
                                lf[e] = __logf(lbm[e] + oml[e] * sg); }
                            u32x2 w; w.x = cvtpk(kk[0], kk[1]); w.y = cvtpk(kk[2], kk[3]);
                            *(u32x2*)(KK + o) = w;
                            w.x = cvtpk(lf[0], lf[1]); w.y = cvtpk(lf[2], lf[3]);
                            *(u32x2*)(LF + o) = w; }
                }
            }
        } else {
            bf16* O = (bf16*)(ar + (sidx == 0 ? AR_QH : sidx == 3 ? AR_VV : sidx == 4 ? AR_GS : sidx == 5 ? AR_XR : AR_YG));
#define EVEN_STORE(FN) do { _Pragma("unroll") for (int ai = 0; ai < 2; ++ai) _Pragma("unroll") for (int m = 0; m < 4; ++m) _Pragma("unroll") for (int bj = 0; bj < 2; ++bj) { \
                const size_t o = (size_t)(row0 + ai * 128 + m * 16) * HGW + cs0 + bj * 128; float v[8]; \
                _Pragma("unroll") for (int e = 0; e < 8; ++e) { const float z = acc[ai][bj][m][e >> 2][e & 3]; v[e] = FN; } \
                u32x4 w; w.x = cvtpk(v[0], v[1]); w.y = cvtpk(v[2], v[3]); w.z = cvtpk(v[4], v[5]); w.w = cvtpk(v[6], v[7]); \
                *(u32x4*)(O + o) = w; } } while (0)
            if (sidx == 3 || sidx == 5) EVEN_STORE(z); else if (sidx == 6) EVEN_STORE(gelu_tanh_(z)); else EVEN_STORE(silu_(z));
#undef EVEN_STORE
        }
    }
};
DI int tau_row(int tau, int d);
struct EpiGate {
    static constexpr bool PERM = true;
    unsigned char* ar; const float* ba; const float* bx;
    DI void operator()(const f32x4 (&acc)[2][2][4][2], const Unit& u, int wr, int wc, int fr, int fq) const {
        const int d = u.pn >> 2, cg = u.pn & 3, ch0 = 128 * cg + 32 * wc + 8 * fq;
        const int bq = u.pm / 9, s0 = (u.pm - 9 * bq) * 256 + wr * 64 + fr;
        bf16* RA = (bf16*)(ar + (d ? AR_LAB : AR_LAF)) + (size_t)(bq * 8 + (ch0 >> 6)) * TB * 64 + (ch0 & 63); bf16* IX = (bf16*)(ar + (d ? AR_BBB : AR_BBF)) + (size_t)(bq * 8 + (ch0 >> 6)) * TB * 64 + (ch0 & 63);
        const f32x4 ba0 = *(const f32x4*)(ba + d * 512 + ch0), ba1 = *(const f32x4*)(ba + d * 512 + ch0 + 4), bx0 = *(const f32x4*)(bx + d * 512 + ch0), bx1 = *(const f32x4*)(bx + d * 512 + ch0 + 4);
#pragma unroll
        for (int ai = 0; ai < 2; ++ai)
#pragma unroll
            for (int m = 0; m < 4; ++m) {
                const int sq = s0 + ai * 128 + m * 16; const size_t o = (size_t)tau_row(sq, d) * 64;
                const f32x4 r0 = acc[ai][0][m][0] + ba0, r1 = acc[ai][0][m][1] + ba1, i0 = acc[ai][1][m][0] + bx0, i1 = acc[ai][1][m][1] + bx1;
                u32x4 w; w.x = cvtpk(r0[0], r0[1]); w.y = cvtpk(r0[2], r0[3]); w.z = cvtpk(r1[0], r1[1]); w.w = cvtpk(r1[2], r1[3]);
                *(u32x4*)(RA + o) = w;
                w.x = cvtpk(i0[0], i0[1]); w.y = cvtpk(i0[2], i0[3]); w.z = cvtpk(i1[0], i1[1]); w.w = cvtpk(i1[2], i1[3]);
                *(u32x4*)(IX + o) = w; }
    }
};
struct EpiQKV {
    static constexpr bool PERM = true;
    unsigned char* ar; const float* qg; const float* kg;
    DI void operator()(const f32x4 (&acc)[2][2][4][2], const Unit& u, int wr, int wc, int fr, int fq) const {
        const int sec = u.pn >> 2, head = (u.pn & 3) * 4 + wc;
        const int row0 = u.pm * 256 + wr * 64 + fr;
        bf16* O = (bf16*)(ar + (sec == 0 ? AR_QB : sec == 1 ? AR_KB : AR_VB));
        float gv[2][8];
#pragma unroll
        for (int bj = 0; bj < 2; ++bj)
#pragma unroll
            for (int e = 0; e < 8; ++e) gv[bj][e] = sec == 0 ? qg[32 * bj + 8 * fq + e] * (0.125f * 1.4426950408889634f) : (sec == 1 ? kg[32 * bj + 8 * fq + e] : 1.f);
#pragma unroll
        for (int ai = 0; ai < 2; ++ai)
#pragma unroll
            for (int m = 0; m < 4; ++m) {
                float ss = 0.f;
#pragma unroll
                for (int bj = 0; bj < 2; ++bj)
#pragma unroll
                    for (int n = 0; n < 2; ++n) { const f32x4 x = acc[ai][bj][m][n]; ss += (x[0] * x[0] + x[1] * x[1]) + (x[2] * x[2] + x[3] * x[3]); }
                { const int ln = 16 * fq + fr; ss += shfl_xor_l(ss, ln, 16); ss += shfl_xor_l(ss, ln, 32); }
                const float rstd = sec < 2 ? rsqrtf(ss * (1.f / 64.f) + EPS) : 1.f;
#pragma unroll
                for (int bj = 0; bj < 2; ++bj) {
                    float v[8];
#pragma unroll
                    for (int e = 0; e < 8; ++e) v[e] = acc[ai][bj][m][e >> 2][e & 3] * rstd * gv[bj][e];
                    u32x4 w; w.x = cvtpk(v[0], v[1]); w.y = cvtpk(v[2], v[3]); w.z = cvtpk(v[4], v[5]); w.w = cvtpk(v[6], v[7]);
                    *(u32x4*)(O + (size_t)(row0 + ai * 128 + m * 16) * DM + head * 64 + 32 * bj + 8 * fq) = w; }
            }
    }
};

#define LDS_WAIT() asm volatile("s_waitcnt lgkmcnt(0)" ::: "memory")
DI unsigned short bfbits(float x) { return (unsigned short)(cvtpk(x, 0.f) & 0xffffu); }

template <int MAP> DI int dst_row(int n) {
    if (MAP == 0) return n;
    if (MAP == 1) { const int nl = n & 255; return (n & ~255) + 128 * ((nl >> 5) & 1) + 32 * (nl >> 6) + (nl & 31); }
    if (MAP == 2) return (n >> 7) * 256 + (n & 127);
    return (n >> 7) * 256 + 128 + (n & 127);
}
template <int MAP> DI void transpose_item(const float* W, int K, int N, bf16* WT, LAS float* scr_, int item, int lane) {
    LAS unsigned char* scr = (LAS unsigned char*)scr_;
    const int nblk = N / 64, kb = item / nblk, nb = item - kb * nblk, k0 = 64 * kb, n0 = 64 * nb;
    const float* src = W + (size_t)k0 * N + n0 + lane;
    float v[64];
#pragma unroll
    for (int i = 0; i < 64; ++i) v[i] = src[(size_t)i * N];
#pragma unroll
    for (int i = 0; i < 32; ++i) *(LAS unsigned*)(scr + lane * 136 + 4 * i) = cvtpk(v[2 * i], v[2 * i + 1]);
    LDS_WAIT(); asm volatile("" ::: "memory");
    const int c = lane & 7;
#pragma unroll
    for (int j = 0; j < 8; ++j) { const int n = (lane >> 3) + 8 * j;
        const u32x2 lo = *(const LAS u32x2*)(scr + n * 136 + 16 * c), hi = *(const LAS u32x2*)(scr + n * 136 + 16 * c + 8);
        u32x4 o; o.x = lo.x; o.y = lo.y; o.z = hi.x; o.w = hi.y;
        *(u32x4*)(WT + (size_t)dst_row<MAP>(n0 + n) * K + k0 + 8 * c) = o; }
    LDS_WAIT(); asm volatile("" ::: "memory");
}

struct Ptrs {
    const float* in[31]; float* out; unsigned char* ws; int ph_lo, ph_hi;
};
enum { I_X = 0, I_C, I_CTX, I_CCTX, I_WMOD, I_BMOD, I_NMIXG, I_NFFNG, I_EVWIN, I_EVWOUT, I_LBLOG, I_ONORMG, I_CONVW, I_CONVB, I_WA, I_BA, I_WX, I_BX, I_LAM,
       I_WQKV, I_WO, I_QG, I_KG, I_RPB, I_FW1, I_FW3, I_FW2, I_ROUTER, I_MW1, I_MW3, I_MW2 };

constexpr int DW_IN = 16 * (EVIN / 64), DW_SQ = 16 * 16, DW_F1 = 16 * (DFF / 64), DW_F2 = (DFF / 64) * 16, DW_QKV = 16 * 48;
constexpr int DW_PER_J = DW_IN + DW_SQ + 2 * DW_F1 + DW_F2 + DW_QKV + DW_SQ;
DI void dense_weight_item(const Ptrs& P, LAS float* scr, int j, int r, int lane) {
    unsigned char* ws = P.ws;
    if (r < DW_IN) { transpose_item<0>(P.in[I_EVWIN] + (size_t)j * DM * EVIN, DM, EVIN, (bf16*)(ws + WS_WIN) + (size_t)j * EVIN * DM, scr, r, lane); return; } r -= DW_IN;
    if (r < DW_SQ) { transpose_item<0>(P.in[I_EVWOUT] + (size_t)j * DM * DM, DM, DM, (bf16*)(ws + WS_WOUT) + (size_t)j * DM * DM, scr, r, lane); return; } r -= DW_SQ;
    if (r < DW_F1) { transpose_item<2>(P.in[I_FW1] + (size_t)j * DM * DFF, DM, DFF, (bf16*)(ws + WS_W13) + (size_t)j * 2 * DFF * DM, scr, r, lane); return; } r -= DW_F1;
    if (r < DW_F1) { transpose_item<3>(P.in[I_FW3] + (size_t)j * DM * DFF, DM, DFF, (bf16*)(ws + WS_W13) + (size_t)j * 2 * DFF * DM, scr, r, lane); return; } r -= DW_F1;
    if (r < DW_F2) { transpose_item<0>(P.in[I_FW2] + (size_t)j * DFF * DM, DFF, DM, (bf16*)(ws + WS_W2) + (size_t)j * DM * DFF, scr, r, lane); return; } r -= DW_F2;
    if (r < DW_QKV) { transpose_item<1>(P.in[I_WQKV] + (size_t)j * DM * 3 * DM, DM, 3 * DM, (bf16*)(ws + WS_WQKV) + (size_t)j * 3 * DM * DM, scr, r, lane); return; } r -= DW_QKV;
    transpose_item<0>(P.in[I_WO] + (size_t)j * DM * DM, DM, DM, (bf16*)(ws + WS_WO) + (size_t)j * DM * DM, scr, r, lane);
}

DI void prologue_phase(const Ptrs& P, LAS unsigned char* lds, int vcu, int G) {
    const int tid = opaque_tid(), lane = tid & 63, wave = __builtin_amdgcn_readfirstlane(tid >> 6);
    unsigned char* ws = P.ws;
    LAS float* scr = (LAS float*)(lds + wave * 16384);
    const int gw = vcu * 8 + wave, NGW = G * 8;
    for (int it = gw; it < DW_PER_J; it += NGW) dense_weight_item(P, scr, 0, it, lane);
    for (int idx = vcu * 512 + tid; idx < 2 * 2048 * 32; idx += G * 512) {
        const int k8 = idx & 31, row = (idx >> 5) & 2047, j = idx >> 16;
        const int pn = row >> 8, p = row & 255, d = pn >> 2, cg = pn & 3, half = p >> 7, ch = 128 * cg + (p & 127), n = ch >> 6, jj = ch & 63, k0 = 256 * (cg >> 1);
        const float* wsrc = P.in[half ? I_WX : I_WA] + (size_t)((j * 2 + d) * 8 + n) * 4096;
        float v[8];
#pragma unroll
        for (int e = 0; e < 8; ++e) { const int ic = k0 + k8 * 8 + e; v[e] = ((ic >> 6) == n) ? wsrc[(ic & 63) * 64 + jj] : 0.f; }
        u32x4 o; o.x = cvtpk(v[0], v[1]); o.y = cvtpk(v[2], v[3]); o.z = cvtpk(v[4], v[5]); o.w = cvtpk(v[6], v[7]);
        *(u32x4*)((bf16*)(ws + WS_WG) + (size_t)j * 2048 * 256 + (size_t)row * 256 + k8 * 8) = o;
    }
    for (int idx = vcu * 512 + tid; idx < 2 * 2 * 512; idx += G * 512) {
        const int col = idx & 511, d = (idx >> 9) & 1, j = idx >> 10;
        const float l0 = P.in[I_LBLOG][(0 * 2 + d) * 512 + col], l1 = P.in[I_LBLOG][(1 * 2 + d) * 512 + col];
        const float lb = (j == 0) ? 0.f : 1.f / (1.f + __expf(l0 - l1));
        float* t = (float*)(ws + WS_LBT) + (size_t)((j * 2 + d) * 3) * 512 + col;
        t[0] = 1.f - lb; t[512] = fmaxf(lb, 1e-30f); t[1024] = 0.f;
        ((float*)(ws + WS_LBT + 65536))[idx] = 8.0f * logsigmoid_(P.in[I_LAM][idx]);
    }
    __syncthreads();
    LAS float* SC = (LAS float*)lds; LAS float* PART = (LAS float*)(lds + 40960);
    for (int idx = tid; idx < 9 * 1024; idx += 512) { const int r = idx >> 10, k = idx & 1023; const float v = r < 8 ? P.in[I_C][r * 1024 + k] : P.in[I_CCTX][k]; SC[idx] = silu_(v); }
    __syncthreads();
    for (int item = vcu; item < 4 * 96; item += G) {
        const int l = item / 96, cb = item - l * 96;
        const float* wp = P.in[I_WMOD] + (size_t)l * DM * 6144 + (size_t)(wave * 128) * 6144 + 64 * cb + lane;
        float acc[9];
#pragma unroll
        for (int r = 0; r < 9; ++r) acc[r] = 0.f;
        for (int k = 0; k < 128; k += 64) {
            float wv[64];
#pragma unroll
            for (int u = 0; u < 64; ++u) wv[u] = wp[(size_t)(k + u) * 6144];
#pragma unroll
            for (int u = 0; u < 64; ++u)
#pragma unroll
                for (int r = 0; r < 9; ++r) acc[r] += SC[r * 1024 + wave * 128 + k + u] * wv[u];
        }
#pragma unroll
        for (int r = 0; r < 9; ++r) PART[(wave * 9 + r) * 64 + lane] = acc[r];
        __syncthreads();
        for (int idx = tid; idx < 576; idx += 512) { const int r = idx >> 6, col = idx & 63; float s = 0.f;
#pragma unroll
            for (int w2 = 0; w2 < 8; ++w2) s += PART[(w2 * 9 + r) * 64 + col];
            ((float*)(ws + WS_MOD))[(size_t)(l * 9 + r) * 6144 + 64 * cb + col] = s + P.in[I_BMOD][l * 6144 + 64 * cb + col]; }
        __syncthreads();
    }
}

constexpr int CW_TAIL = 71104;
constexpr int CW_TAILG = 76800;
constexpr int CW_LB = 74240;
constexpr int CW_GRP = 71296;
constexpr int CW_SUB = 71040;
constexpr int CW_Q = 70016;
DI void moe_convert_queue(const Ptrs& P, LAS unsigned char* lds, int j, int maxpulls) {
    const int tid = opaque_tid(), lane = tid & 63, wave = __builtin_amdgcn_readfirstlane(tid >> 6);
    LAS float* scr = (LAS float*)(lds + wave * 16384);
    LAS int* qs = (LAS int*)(lds + RING_BYTES + 64);
    unsigned* head = (unsigned*)(P.ws + WS_CTL) + CW_Q + 64 * j;
    constexpr int I_F1 = 16 * (DFF / 64), I_F2 = (DFF / 64) * 16, PER_E = 2 * I_F1 + I_F2, NIT = NEXP * PER_E;
    const int nit = NIT + (j == 0 ? DW_PER_J : 0);
    for (int pull = 0; pull < maxpulls; ++pull) {
        __syncthreads();
        if (tid == 0) *qs = (int)__hip_atomic_fetch_add(head, 1u, __ATOMIC_RELAXED, __HIP_MEMORY_SCOPE_AGENT);
        __syncthreads();
        const int base = *qs * 32;
        if (base >= nit) break;
        for (int k = 0; k < 4; ++k) {
            const int it = base + k * 8 + wave;
            if (it >= nit) break;
            if (it >= NIT) { dense_weight_item(P, scr, 1, it - NIT, lane); continue; }
            const int e = it / PER_E; int r = it - e * PER_E; const size_t wo = (size_t)(j * NEXP + e) * DM * DFF;
            bf16* b13 = (bf16*)(P.ws + WS_MW13) + (size_t)e * 2 * DFF * DM; bf16* b2 = (bf16*)(P.ws + WS_MW2) + (size_t)e * DM * DFF;
            if (r < I_F1) { transpose_item<2>(P.in[I_MW1] + wo, DM, DFF, b13, scr, r, lane); continue; } r -= I_F1;
            if (r < I_F1) { transpose_item<3>(P.in[I_MW3] + wo, DM, DFF, b13, scr, r, lane); continue; } r -= I_F1;
            transpose_item<0>(P.in[I_MW2] + wo, DFF, DM, b2, scr, r, lane);
        }
    }
    __syncthreads();
}

template <bool ROUTER, bool FIRST>
DI void norm_phase(const Ptrs& P, int vcu, int G, int layer, int which, bool combine, bool latonly, int npart, bool hasd) {
    constexpr int NB = ROUTER ? 3 : 5;
    const int tid = opaque_tid(), lane = tid & 63, wave = __builtin_amdgcn_readfirstlane(tid >> 6);
    unsigned char* ws = P.ws;
    bf16* R = (bf16*)(ws + WS_R); bf16* U = (bf16*)(ws + WS_U);
    const float* MOD = (const float*)(ws + WS_MOD);
    const float* gsrc = P.in[which ? I_NFFNG : I_NMIXG] + layer * DM;
    const bf16* Y32 = (const bf16*)(ws + WS_AR + AR_Y32); const bf16* Y2t = (const bf16*)(ws + WS_PART);
    const unsigned* yflag = (const unsigned*)(ws + WS_CTL) + CW_YF + 1024 * ((layer - 1) >> 1);
    const int* SLOT = (const int*)(ws + WS_SLOT); const float* TOPW = (const float*)(ws + WS_TOPW);
    const bf16* Dd = (const bf16*)(ws + WS_D);
    f32x4 gv[4];
#pragma unroll
    for (int jx = 0; jx < 4; ++jx) gv[jx] = *(const f32x4*)(gsrc + 256 * jx + 4 * lane);
    f32x4 wr0[ROUTER ? 16 : 1], wr1[ROUTER ? 16 : 1];
    if (ROUTER) {
        const float* wrp = P.in[I_ROUTER] + (size_t)(layer >> 1) * DM * NEXP;
#pragma unroll
        for (int jx = 0; jx < 4; ++jx)
#pragma unroll
            for (int e4 = 0; e4 < 4; ++e4) { const float* p = wrp + (size_t)(256 * jx + 4 * lane + e4) * 8; wr0[jx * 4 + e4] = *(const f32x4*)p; wr1[jx * 4 + e4] = *(const f32x4*)(p + 4); }
    }
    const int nper = latonly ? 8 : 9;
    for (int vw = vcu * 8 + wave; vw < 2048; vw += G * 8) {
        int cnt[8];
#pragma unroll
        for (int e = 0; e < 8; ++e) cnt[e] = 0;
        for (int i0 = 0; i0 < nper; i0 += NB) {
            f32x4 xf[FIRST ? NB : 1][4]; u32x2 rr[FIRST ? 1 : NB][4], dd[NB][4], ya[NB][4], yb[NB][4];
            int sl0[NB], sl1[NB]; float tw0[NB], tw1[NB];
#pragma unroll
            for (int q = 0; q < NB; ++q) { sl0[q] = 0; sl1[q] = 0; tw0[q] = 0.f; tw1[q] = 0.f;
                if (combine && i0 + q < nper) { const int row = vw * nper + i0 + q; sl0[q] = SLOT[2 * row]; sl1[q] = SLOT[2 * row + 1]; tw0[q] = TOPW[2 * row]; tw1[q] = TOPW[2 * row + 1]; } }
#pragma unroll
            for (int q = 0; q < NB; ++q) {
                if (i0 + q < nper) {
                    const int tok = vw * nper + i0 + q;
                    const int row = latonly ? tok + 256 * ((tok >> 11) + 1) : tok;
                    if (FIRST) { const int b = row / TB, s = row - b * TB; const bool isctx = s < CTXL;
                        const float* src = isctx ? P.in[I_CTX] + (size_t)(b * CTXL + s) * DM : P.in[I_X] + (size_t)(b * SEQ + s - CTXL) * DM;
#pragma unroll
                        for (int jx = 0; jx < 4; ++jx) xf[FIRST ? q : 0][jx] = *(const f32x4*)(src + 256 * jx + 4 * lane);
                    } else {
#pragma unroll
                        for (int jx = 0; jx < 4; ++jx) rr[FIRST ? 0 : q][jx] = *(const u32x2*)(R + (size_t)row * DM + 256 * jx + 4 * lane);
                    }
                    if (hasd) {
#pragma unroll
                        for (int jx = 0; jx < 4; ++jx) dd[q][jx] = *(const u32x2*)(Dd + (size_t)row * DM + 256 * jx + 4 * lane);
                    }
                    if (combine) {
#pragma unroll
                        for (int jx = 0; jx < 4; ++jx) { ya[q][jx] = *(const u32x2*)(Y32 + (size_t)sl0[q] * DM + 256 * jx + 4 * lane); yb[q][jx] = *(const u32x2*)(Y32 + (size_t)sl1[q] * DM + 256 * jx + 4 * lane); }
                    }
                }
            }
#pragma unroll
            for (int q = 0; q < NB; ++q) {
                if (i0 + q < nper) {
                    const int tok = vw * nper + i0 + q;
                    const int row = latonly ? tok + 256 * ((tok >> 11) + 1) : tok;
                    const int b = row / TB, s = row - b * TB; const bool isctx = s < CTXL; const int mrow = isctx ? 8 : b;
                    f32x4 v[4];
#pragma unroll
                    for (int jx = 0; jx < 4; ++jx) { if (FIRST) v[jx] = xf[FIRST ? q : 0][jx]; else { const u32x2 rw = rr[FIRST ? 0 : q][jx]; v[jx] = (f32x4){bflo(rw.x), bfhi(rw.x), bflo(rw.y), bfhi(rw.y)}; } }
                    if (combine) {
                        const int s0 = sl0[q], s1 = sl1[q]; const float w0 = tw0[q], w1 = tw1[q];
                        const float* gt = MOD + (size_t)((layer - 1) * 9 + mrow) * 6144 + 5 * 1024;
#pragma unroll
                        for (int jx = 0; jx < 4; ++jx) { const u32x2 a0 = ya[q][jx], a1 = yb[q][jx];
                            f32x4 y0 = {bflo(a0.x), bfhi(a0.x), bflo(a0.y), bfhi(a0.y)}, y1 = {bflo(a1.x), bfhi(a1.x), bflo(a1.y), bfhi(a1.y)};
                            const unsigned f0 = yflag[(s0 >> 8) * 4 + jx], f1 = yflag[(s1 >> 8) * 4 + jx];
                            if (f0) { const u32x2 t = *(const u32x2*)(Y2t + (size_t)(f0 - 1) * 65536 + (s0 & 255) * 256 + 4 * lane); y0 = y0 + (f32x4){bflo(t.x), bfhi(t.x), bflo(t.y), bfhi(t.y)}; }
                            if (f1) { const u32x2 t = *(const u32x2*)(Y2t + (size_t)(f1 - 1) * 65536 + (s1 & 255) * 256 + 4 * lane); y1 = y1 + (f32x4){bflo(t.x), bfhi(t.x), bflo(t.y), bfhi(t.y)}; }
                            v[jx] = v[jx] + *(const f32x4*)(gt + 256 * jx + 4 * lane) * (w0 * y0 + w1 * y1); }
                    }
                    if (hasd) {
#pragma unroll
                        for (int jx = 0; jx < 4; ++jx) { const u32x2 dw = dd[q][jx]; v[jx] = v[jx] + (f32x4){bflo(dw.x), bfhi(dw.x), bflo(dw.y), bfhi(dw.y)}; } }
                    const bool addp = (npart > 0) && isctx;
                    if (addp) { const float* pp = (const float*)(ws + WS_PART) + (size_t)(b * CTXL + s) * DM;
                        for (int p = 0; p < npart; ++p)
#pragma unroll
                            for (int jx = 0; jx < 4; ++jx) v[jx] = v[jx] + *(const f32x4*)(pp + (size_t)p * 2048 * DM + 256 * jx + 4 * lane); }
#pragma unroll
                    for (int jx = 0; jx < 4; ++jx) { u32x2 o; o.x = cvtpk(v[jx][0], v[jx][1]); o.y = cvtpk(v[jx][2], v[jx][3]); *(u32x2*)(R + (size_t)row * DM + 256 * jx + 4 * lane) = o; }
                    float ss = 0.f;
#pragma unroll
                    for (int jx = 0; jx < 4; ++jx) ss += (v[jx][0] * v[jx][0] + v[jx][1] * v[jx][1]) + (v[jx][2] * v[jx][2] + v[jx][3] * v[jx][3]);
                    const float rstd = rsqrtf(wave_sum(ss) * (1.f / DM) + EPS);
                    const float* mp = MOD + (size_t)(layer * 9 + mrow) * 6144 + (which ? 3 : 0) * 1024;
                    f32x4 uu[4];
#pragma unroll
                    for (int jx = 0; jx < 4; ++jx) { const f32x4 sh = *(const f32x4*)(mp + 256 * jx + 4 * lane), sc = *(const f32x4*)(mp + 1024 + 256 * jx + 4 * lane);
                        uu[jx] = v[jx] * rstd * gv[jx] * (1.f + sc) + sh;
                        u32x2 o; o.x = cvtpk(uu[jx][0], uu[jx][1]); o.y = cvtpk(uu[jx][2], uu[jx][3]);
                        *(u32x2*)(U + (size_t)row * DM + 256 * jx + 4 * lane) = o; }
                    if (ROUTER) {
                        float lg[8];
#pragma unroll
                        for (int e = 0; e < 8; ++e) lg[e] = 0.f;
#pragma unroll
                        for (int jx = 0; jx < 4; ++jx)
#pragma unroll
                            for (int e4 = 0; e4 < 4; ++e4) { const float uv = uu[jx][e4]; const f32x4 a = wr0[jx * 4 + e4], c2 = wr1[jx * 4 + e4];
                                lg[0] += uv * a[0]; lg[1] += uv * a[1]; lg[2] += uv * a[2]; lg[3] += uv * a[3]; lg[4] += uv * c2[0]; lg[5] += uv * c2[1]; lg[6] += uv * c2[2]; lg[7] += uv * c2[3]; }
#pragma unroll
                        for (int e = 0; e < 8; ++e) lg[e] = wave_sum(lg[e]);
                        int e0 = 0; float v0 = lg[0];
#pragma unroll
                        for (int e = 1; e < 8; ++e) if (lg[e] > v0) { v0 = lg[e]; e0 = e; }
                        int e1 = -1; float v1 = -3.0e38f;
#pragma unroll
                        for (int e = 0; e < 8; ++e) if (e != e0 && lg[e] > v1) { v1 = lg[e]; e1 = e; }
                        e0 = __builtin_amdgcn_readfirstlane(e0); e1 = __builtin_amdgcn_readfirstlane(e1);
                        const float w0 = 1.f / (1.f + __expf(v1 - v0));
#pragma unroll
                        for (int e = 0; e < 8; ++e) cnt[e] += (e0 == e ? 1 : 0) + (e1 == e ? 1 : 0);
                        if (lane == 0) { ((int*)(ws + WS_TOPE))[tok] = e0 | (e1 << 8); ((float*)(ws + WS_TOPW))[2 * tok] = w0; ((float*)(ws + WS_TOPW))[2 * tok + 1] = 1.f - w0; }
                    }
                }
            }
        }
        if (ROUTER) {
            int c = 0;
#pragma unroll
            for (int e = 0; e < 8; ++e) c = (lane == e) ? cnt[e] : c;
            if (lane < 8) ((int*)(ws + WS_WCNT))[vw * 8 + lane] = c;
        }
    }
}

DI void dispatch_phase(const Ptrs& P, LAS unsigned char* lds, int vcu, int G, bool latonly) {
    const int tid = opaque_tid(), lane = tid & 63, wave = __builtin_amdgcn_readfirstlane(tid >> 6);
    unsigned char* ws = P.ws;
    const int* WCNT = (const int*)(ws + WS_WCNT); const int* TOPE = (const int*)(ws + WS_TOPE);
    int* SLOT = (int*)(ws + WS_SLOT); const bf16* U = (const bf16*)(ws + WS_U); bf16* UG = (bf16*)(ws + WS_AR + AR_UG);
    LAS int* TOTL = (LAS int*)(lds + 65536 + 8192); LAS int* PREL = TOTL + 8;
    const int nper = latonly ? 8 : 9;
    for (int vg = vcu; vg < 256; vg += G) {
        __syncthreads();
        {
            const int e = wave; int full = 0, part = 0; int cvv[32];
#pragma unroll
            for (int i = 0; i < 32; ++i) cvv[i] = WCNT[(32 * lane + i) * 8 + e];
#pragma unroll
            for (int i = 0; i < 32; ++i) { const int vw = 32 * lane + i; full += cvv[i]; part += (vw < 8 * vg) ? cvv[i] : 0; }
            full = (int)wave_sum((float)full); part = (int)wave_sum((float)part);
            if (lane == 0) { TOTL[e] = full; PREL[e] = part; }
        }
        int wpre = ((lane >> 3) < wave) ? WCNT[vg * 64 + lane] : 0;
        wpre += shfl_xor_l(wpre, lane, 8); wpre += shfl_xor_l(wpre, lane, 16); wpre += shfl_xor_l(wpre, lane, 32);
        __syncthreads();
        int start[8]; int base = 0;
#pragma unroll
        for (int e = 0; e < 8; ++e) { const int tot = TOTL[e]; const int st = base + PREL[e] + __builtin_amdgcn_readlane(wpre, e);
            start[e] = __builtin_amdgcn_readfirstlane(st); base += (tot + 255) & ~255; }
        if (vg == 0 && wave == 0) {
            int* TILE = (int*)(ws + WS_CTL) + CW_TILE; int bb = 0;
#pragma unroll
            for (int e = 0; e < 8; ++e) { const int nt = (TOTL[e] + 255) >> 8; for (int t = lane; t < nt; t += 64) TILE[(bb >> 8) + t] = e; bb += nt << 8; }
            if (lane == 0) TILE[160] = bb >> 8;
        }
        const int vw = vg * 8 + wave;
        constexpr int NB = 3;
        for (int i0 = 0; i0 < nper; i0 += NB) {
            int ee[NB]; u32x4 ua[NB], ub[NB];
#pragma unroll
            for (int q = 0; q < NB; ++q) { ee[q] = 0;
                if (i0 + q < nper) { const int tok = vw * nper + i0 + q; const int row = latonly ? tok + 256 * ((tok >> 11) + 1) : tok;
                    ee[q] = TOPE[tok]; ua[q] = *(const u32x4*)(U + (size_t)row * DM + 16 * lane); ub[q] = *(const u32x4*)(U + (size_t)row * DM + 16 * lane + 8); } }
#pragma unroll
            for (int q = 0; q < NB; ++q) {
                if (i0 + q < nper) { const int tok = vw * nper + i0 + q;
                    const int e01 = __builtin_amdgcn_readfirstlane(ee[q]); const int e0 = e01 & 255, e1 = e01 >> 8;
                    int s0 = 0, s1 = 0;
#pragma unroll
                    for (int e = 0; e < 8; ++e) { if (e0 == e) { s0 = start[e]; start[e] += 1; } if (e1 == e) { s1 = start[e]; start[e] += 1; } }
                    if (lane == 0) { SLOT[2 * tok] = s0; SLOT[2 * tok + 1] = s1; }
                    *(u32x4*)(UG + (size_t)s0 * DM + 16 * lane) = ua[q]; *(u32x4*)(UG + (size_t)s0 * DM + 16 * lane + 8) = ub[q];
                    *(u32x4*)(UG + (size_t)s1 * DM + 16 * lane) = ua[q]; *(u32x4*)(UG + (size_t)s1 * DM + 16 * lane + 8) = ub[q]; } }
        }
    }
    __syncthreads();
}

DI void final_phase(const Ptrs& P, int vcu, int G) {
    const int tid = opaque_tid(), lane = tid & 63, wave = __builtin_amdgcn_readfirstlane(tid >> 6);
    unsigned char* ws = P.ws;
    const bf16* R = (const bf16*)(ws + WS_R); const float* MOD = (const float*)(ws + WS_MOD); const bf16* Y32 = (const bf16*)(ws + WS_AR + AR_Y32);
    const bf16* Y2t = (const bf16*)(ws + WS_PART); const unsigned* yflag = (const unsigned*)(ws + WS_CTL) + CW_YF + 1024;
    const int* SLOT = (const int*)(ws + WS_SLOT); const float* TOPW = (const float*)(ws + WS_TOPW);
    constexpr int NB = 2;
    const int stride = G * 8;
    for (int tok0 = vcu * 8 + wave; tok0 < NBATCH * SEQ; tok0 += NB * stride) {
        int sl0[NB], sl1[NB]; float tw0[NB], tw1[NB]; u32x2 ya[NB][4], yb[NB][4], rr[NB][4];
#pragma unroll
        for (int q = 0; q < NB; ++q) { const int tok = tok0 + q * stride; sl0[q] = 0; sl1[q] = 0; tw0[q] = 0.f; tw1[q] = 0.f;
            if (tok < NBATCH * SEQ) { sl0[q] = SLOT[2 * tok]; sl1[q] = SLOT[2 * tok + 1]; tw0[q] = TOPW[2 * tok]; tw1[q] = TOPW[2 * tok + 1]; } }
#pragma unroll
        for (int q = 0; q < NB; ++q) { const int tok = tok0 + q * stride;
            if (tok < NBATCH * SEQ) { const int b = tok >> 11, row = tok + 256 * (b + 1);
#pragma unroll
                for (int jx = 0; jx < 4; ++jx) { const int o = 256 * jx + 4 * lane;
                    ya[q][jx] = *(const u32x2*)(Y32 + (size_t)sl0[q] * DM + o); yb[q][jx] = *(const u32x2*)(Y32 + (size_t)sl1[q] * DM + o); rr[q][jx] = *(const u32x2*)(R + (size_t)row * DM + o); } } }
#pragma unroll
        for (int q = 0; q < NB; ++q) { const int tok = tok0 + q * stride;
            if (tok < NBATCH * SEQ) { const int b = tok >> 11;
                const int s0 = sl0[q], s1 = sl1[q]; const float w0 = tw0[q], w1 = tw1[q];
                const float* gt = MOD + (size_t)(3 * 9 + b) * 6144 + 5 * 1024;
#pragma unroll
                for (int jx = 0; jx < 4; ++jx) { const int o = 256 * jx + 4 * lane;
                    const u32x2 a0 = ya[q][jx], a1 = yb[q][jx], rw = rr[q][jx];
                    f32x4 y0 = {bflo(a0.x), bfhi(a0.x), bflo(a0.y), bfhi(a0.y)}, y1 = {bflo(a1.x), bfhi(a1.x), bflo(a1.y), bfhi(a1.y)};
                    const unsigned f0 = yflag[(s0 >> 8) * 4 + jx], f1 = yflag[(s1 >> 8) * 4 + jx];
                    if (f0) { const u32x2 t = *(const u32x2*)(Y2t + (size_t)(f0 - 1) * 65536 + (s0 & 255) * 256 + 4 * lane); y0 = y0 + (f32x4){bflo(t.x), bfhi(t.x), bflo(t.y), bfhi(t.y)}; }
                    if (f1) { const u32x2 t = *(const u32x2*)(Y2t + (size_t)(f1 - 1) * 65536 + (s1 & 255) * 256 + 4 * lane); y1 = y1 + (f32x4){bflo(t.x), bfhi(t.x), bflo(t.y), bfhi(t.y)}; }
                    *(f32x4*)(P.out + (size_t)tok * DM + o) = (f32x4){bflo(rw.x), bfhi(rw.x), bflo(rw.y), bfhi(rw.y)} + *(const f32x4*)(gt + o) * (w0 * y0 + w1 * y1); } } }
    }
}

DI void conv_phase(const Ptrs& P, int vcu, int G, int jl) {
    unsigned char* ar = P.ws + WS_AR;
    const bf16* XR = (const bf16*)(ar + AR_XR); bf16* XC = (bf16*)(ar + AR_XC);
    const float* cw = P.in[I_CONVW] + (size_t)jl * 4 * 512; const float* cb = P.in[I_CONVB] + (size_t)jl * 512;
    const int tid = opaque_tid(), c4 = (tid & 127) * 4, rgp = tid >> 7;
    f32x4 wt[4];
#pragma unroll
    for (int jt = 0; jt < 4; ++jt) wt[jt] = *(const f32x4*)(cw + jt * 512 + c4);
    const f32x4 bias = *(const f32x4*)(cb + c4);
    for (int blk = vcu; blk < T / 72; blk += G) {
        const int r0 = blk * 72 + rgp * 18; const int b = r0 / TB, s0 = r0 - b * TB;
        u32x2 xw[21];
#pragma unroll
        for (int k = 0; k < 21; ++k) { int row = r0 - 2 + k; row = row < 0 ? 0 : (row > T - 1 ? T - 1 : row); xw[k] = *(const u32x2*)(XR + (size_t)row * HGW + c4); }
#pragma unroll
        for (int i = 0; i < 18; ++i) { const int s = s0 + i; const int lo = s < CTXL ? 0 : CTXL, hi = s < CTXL ? CTXL : TB;
            f32x4 a = bias;
#pragma unroll
            for (int jt = 0; jt < 4; ++jt) { const int ss = s + jt - 2; const bool ok = ss >= lo && ss < hi;
                const unsigned x0 = ok ? xw[i + jt].x : 0u, x1 = ok ? xw[i + jt].y : 0u;
                a = a + wt[jt] * (f32x4){bflo(x0), bfhi(x0), bflo(x1), bfhi(x1)}; }
            u32x2 o; o.x = cvtpk(a[0], a[1]); o.y = cvtpk(a[2], a[3]);
            *(u32x2*)(XC + (size_t)(r0 + i) * HGW + c4) = o; }
    }
}

DI void merge_phase(const Ptrs& P, int vcu, int G, int jl) {
    const int tid = opaque_tid(), lane = tid & 63, wave = __builtin_amdgcn_readfirstlane(tid >> 6);
    unsigned char* ar = P.ws + WS_AR;
    const bf16* OF = (const bf16*)(ar + AR_OF); const bf16* OB = (const bf16*)(ar + AR_OB); const bf16* HF = (const bf16*)(ar + AR_HF); const bf16* HB = (const bf16*)(ar + AR_HB);
    const bf16* GS = (const bf16*)(ar + AR_GS); const bf16* YG = (const bf16*)(ar + AR_YG); bf16* MIX = (bf16*)(ar + AR_MIX);
    const float* on = P.in[I_ONORMG] + (size_t)jl * 512 + 8 * lane;
    float ong[8];
#pragma unroll
    for (int e = 0; e < 8; ++e) ong[e] = on[e];
    constexpr int NB = 3;
    const int stride = G * 8;
    for (int row0 = vcu * 8 + wave; row0 < T; row0 += NB * stride) {
        u32x4 ra[NB], rc[NB], rg[NB], rf[NB], rb[NB], ry[NB];
#pragma unroll
        for (int q = 0; q < NB; ++q) { const int row = row0 + q * stride;
            if (row < T) { const size_t o = (size_t)row * HGW + 8 * lane;
                ra[q] = *(const u32x4*)(OF + o); rc[q] = *(const u32x4*)(OB + o); rg[q] = *(const u32x4*)(GS + o); rf[q] = *(const u32x4*)(HF + o); rb[q] = *(const u32x4*)(HB + o); ry[q] = *(const u32x4*)(YG + o); } }
#pragma unroll
        for (int q = 0; q < NB; ++q) { const int row = row0 + q * stride;
            if (row < T) {
                const u32x4 a = ra[q], c2 = rc[q], g = rg[q], hf = rf[q], hb = rb[q], y = ry[q];
                float hg[8] = {bflo(a.x) + bflo(c2.x), bfhi(a.x) + bfhi(c2.x), bflo(a.y) + bflo(c2.y), bfhi(a.y) + bfhi(c2.y), bflo(a.z) + bflo(c2.z), bfhi(a.z) + bfhi(c2.z), bflo(a.w) + bflo(c2.w), bfhi(a.w) + bfhi(c2.w)};
                const float gg[8] = {bflo(g.x), bfhi(g.x), bflo(g.y), bfhi(g.y), bflo(g.z), bfhi(g.z), bflo(g.w), bfhi(g.w)};
                float ss = 0.f;
#pragma unroll
                for (int e = 0; e < 8; ++e) ss += hg[e] * hg[e];
                const float rstd = rsqrtf(wave_sum(ss) * (1.f / 512.f) + EPS);
#pragma unroll
                for (int e = 0; e < 8; ++e) hg[e] = hg[e] * rstd * ong[e] * gg[e];
                u32x4 w; w.x = cvtpk(hg[0], hg[1]); w.y = cvtpk(hg[2], hg[3]); w.z = cvtpk(hg[4], hg[5]); w.w = cvtpk(hg[6], hg[7]);
                *(u32x4*)(MIX + (size_t)row * DM + 8 * lane) = w;
                w.x = cvtpk((bflo(hf.x) + bflo(hb.x)) * bflo(y.x), (bfhi(hf.x) + bfhi(hb.x)) * bfhi(y.x));
                w.y = cvtpk((bflo(hf.y) + bflo(hb.y)) * bflo(y.y), (bfhi(hf.y) + bfhi(hb.y)) * bfhi(y.y));
                w.z = cvtpk((bflo(hf.z) + bflo(hb.z)) * bflo(y.z), (bfhi(hf.z) + bfhi(hb.z)) * bfhi(y.z));
                w.w = cvtpk((bflo(hf.w) + bflo(hb.w)) * bflo(y.w), (bfhi(hf.w) + bfhi(hb.w)) * bfhi(y.w));
                *(u32x4*)(MIX + (size_t)row * DM + 512 + 8 * lane) = w;
            } }
    }
}

DI int tau_row(int tau, int d) { return tau < CTXL ? (d ? CTXL - 1 - tau : tau) : CTXL + (d ? SEQ - 1 - (tau - CTXL) : (tau - CTXL)); }

DI void rg_coeff(float ra, float ix, float xc, float lsl, float& la, float& bb) {
    la = sigmoid_(ra) * lsl;
    const float y = 2.f * la;
    const float ser = -y * (1.f + y * (0.5f + y * (0.16666667f + y * (0.041666667f + y * 0.0083333333f))));
    const float om = (y > -0.3f) ? ser : 1.f - __expf(y);
    bb = __builtin_amdgcn_sqrtf(fmaxf(om, 0.f)) * (sigmoid_(ix) * xc);
}
DI void rgscan_item(LAS unsigned char* lds, int item, unsigned char* ar, const float* lslp) {
    const int tid = opaque_tid(), lane = tid & 63, w = __builtin_amdgcn_readfirstlane(tid >> 6);
    const int d = item >> 6, b = (item >> 3) & 7, cb = item & 7, ch = 64 * cb + lane;
    bf16* RA = (bf16*)(ar + (d ? AR_LAB : AR_LAF)); bf16* IX = (bf16*)(ar + (d ? AR_BBB : AR_BBF)); const bf16* XC = (const bf16*)(ar + AR_XC); bf16* HD = (bf16*)(ar + (d ? AR_HB : AR_HF));
    const float lsl = lslp[d * 512 + ch];
    LAS float* SEG = (LAS float*)lds;
    const int tau0 = 288 * w;
    float h = 0.f, sla = 0.f;
#define RG_ROW(tt) ((size_t)(b * TB + tau_row(tau0 + (tt), d)) * HGW)
    const unsigned chu = (unsigned)ch, lu = (unsigned)lane;
    typedef const __attribute__((address_space(1))) bf16* gcptr; typedef __attribute__((address_space(1))) bf16* gptr;
    auto sp = [](const bf16* q0) { gcptr q = (gcptr)q0; asm volatile("" : "+s"(q)); return q; };
    auto spw = [](bf16* q0) { gptr q = (gptr)q0; asm volatile("" : "+s"(q)); return q; };
#define RG_USE(S) asm volatile("" :: "v"((unsigned)S[0]), "v"((unsigned)S[1]), "v"((unsigned)S[2]), "v"((unsigned)S[3]), "v"((unsigned)S[4]), "v"((unsigned)S[5]), "v"((unsigned)S[6]), "v"((unsigned)S[7]), \
        "v"((unsigned)S[8]), "v"((unsigned)S[9]), "v"((unsigned)S[10]), "v"((unsigned)S[11]), "v"((unsigned)S[12]), "v"((unsigned)S[13]), "v"((unsigned)S[14]), "v"((unsigned)S[15]))
#define RG_BLK(tt) (((size_t)(b * 8 + cb) * TB + (size_t)(tau0 + (tt))) * 64)
#define RG_LD1(Sr, Sx, Sc, tb) do { _Pragma("unroll") for (int i = 0; i < 16; ++i) { const size_t o = RG_ROW((tb) + i), ob = RG_BLK((tb) + i); Sr[i] = sp(RA + ob)[lu]; Sx[i] = sp(IX + ob)[lu]; Sc[i] = sp(XC + o)[chu]; } } while (0)
#define RG_CP1(Sr, Sx, Sc, tb) do { _Pragma("unroll") for (int i = 0; i < 16; i += 2) { const size_t o0 = RG_BLK((tb) + i), o1 = RG_BLK((tb) + i + 1); \
            const f32x2 ra2 = {bf2f(Sr[i]), bf2f(Sr[i + 1])}, ix2 = {bf2f(Sx[i]), bf2f(Sx[i + 1])}, xc2 = {bf2f(Sc[i]), bf2f(Sc[i + 1])}; \
            const f32x2 ta = ra2 * nl2e2, tx = ix2 * nl2e2; \
            const f32x2 da = (f32x2){__builtin_amdgcn_exp2f(ta[0]), __builtin_amdgcn_exp2f(ta[1])} + one2, dx = (f32x2){__builtin_amdgcn_exp2f(tx[0]), __builtin_amdgcn_exp2f(tx[1])} + one2; \
            const f32x2 sa = {__builtin_amdgcn_rcpf(da[0]), __builtin_amdgcn_rcpf(da[1])}, sx = {__builtin_amdgcn_rcpf(dx[0]), __builtin_amdgcn_rcpf(dx[1])}; \
            const f32x2 af = (sa * lsl2) * l2e2;                                             \
            const f32x2 om = one2 - (f32x2){__builtin_amdgcn_exp2f(af[0]), __builtin_amdgcn_exp2f(af[1])}; \
            const unsigned omw = cvtpk(om[0], om[1]); const f32x2 omq = {bflo(omw), bfhi(omw)}; \
            const f32x2 au = one2 - omq, s2 = omq * (two2 - omq);                            \
            const f32x2 bb2 = (f32x2){__builtin_amdgcn_sqrtf(s2[0]), __builtin_amdgcn_sqrtf(s2[1])} * (sx * xc2); \
            const unsigned bbw = cvtpk(bb2[0], bb2[1]); \
            spw(RA + o0)[lu] = (unsigned short)(omw & 0xffffu); spw(RA + o1)[lu] = (unsigned short)(omw >> 16); \
            spw(IX + o0)[lu] = (unsigned short)(bbw & 0xffffu); spw(IX + o1)[lu] = (unsigned short)(bbw >> 16); \
            h = au[0] * h + bflo(bbw); h = au[1] * h + bfhi(bbw); ap *= au[0] * au[1]; } } while (0)
    const f32x2 nl2e2 = {-1.4426950408889634f, -1.4426950408889634f}, l2e2 = {1.4426950408889634f, 1.4426950408889634f}, one2 = {1.f, 1.f}, two2 = {2.f, 2.f}, lsl2 = {lsl, lsl};
    float ap = 1.f;
    {
        unsigned short Ar[16], Ax[16], Ac[16], Br[16], Bx[16], Bc[16];
        RG_LD1(Ar, Ax, Ac, 0);
        for (int t0 = 0; t0 < 288; t0 += 32) {
            RG_USE(Ar); RG_USE(Ax); RG_USE(Ac);
            RG_LD1(Br, Bx, Bc, t0 + 16);
            RG_CP1(Ar, Ax, Ac, t0);
            RG_USE(Br); RG_USE(Bx); RG_USE(Bc);
            if (t0 + 32 < 288) RG_LD1(Ar, Ax, Ac, t0 + 32);
            RG_CP1(Br, Bx, Bc, t0 + 16);
        }
    }
    __syncthreads();
    SEG[(w * 2 + 0) * 64 + lane] = ap; SEG[(w * 2 + 1) * 64 + lane] = h;
    __syncthreads();
    h = 0.f;
    for (int w2 = 0; w2 < w; ++w2) h = SEG[(w2 * 2 + 0) * 64 + lane] * h + SEG[(w2 * 2 + 1) * 64 + lane];
#define RG_LD2(Sl, Sb, tb) do { _Pragma("unroll") for (int i = 0; i < 16; ++i) { const size_t ob = RG_BLK((tb) + i); Sl[i] = sp(RA + ob)[lu]; Sb[i] = sp(IX + ob)[lu]; } } while (0)
#define RG_CP2(Sl, Sb, tb) do { _Pragma("unroll") for (int i = 0; i < 16; ++i) { const size_t o = RG_ROW((tb) + i); h = (1.f - bf2f(Sl[i])) * h + bf2f(Sb[i]); spw(HD + o)[chu] = bfbits(h); } } while (0)
    {
        unsigned short Al[16], Ab[16], Bl[16], Bb[16];
        RG_LD2(Al, Ab, 0);
        for (int t0 = 0; t0 < 288; t0 += 32) {
            RG_USE(Al); RG_USE(Ab);
            RG_LD2(Bl, Bb, t0 + 16);
            RG_CP2(Al, Ab, t0);
            RG_USE(Bl); RG_USE(Bb);
            if (t0 + 32 < 288) RG_LD2(Al, Ab, t0 + 32);
            RG_CP2(Bl, Bb, t0 + 16);
        }
    }
#undef RG_ROW
#undef RG_BLK
#undef RG_USE
#undef RG_LD1
#undef RG_CP1
#undef RG_LD2
#undef RG_CP2
}

DI void gla_item(LAS unsigned char* lds, int item, unsigned char* ar) {
    const int tid = opaque_tid(), lane = tid & 63, w = __builtin_amdgcn_readfirstlane(tid >> 6);
    const int head = item & 3, b = (item >> 2) & 7, d = item >> 5;
    const bf16* Qh = (const bf16*)(ar + AR_QH); const bf16* KK = (const bf16*)(ar + (d ? AR_KKB : AR_KKF)); const bf16* LF = (const bf16*)(ar + (d ? AR_LFB : AR_LFF));
    const bf16* Vv = (const bf16*)(ar + AR_VV); bf16* Od = (bf16*)(ar + (d ? AR_OB : AR_OF));
    constexpr int RS = 272, BUF = 36864, QS = 0, QM = 8704, KM = 17408, VI = 26112, FAC = 34816, TOTP = 2 * BUF, NCH = 72;
    constexpr float L2E = 1.4426950408889634f;
    const int r = lane & 31, h = lane >> 5, blk = (lane >> 4) & 1, q4 = (lane & 15) >> 2, p4 = lane & 3;
    const int ptid = tid & 255, cp = ptid & 63, qq = __builtin_amdgcn_readfirstlane(ptid >> 6);
    const unsigned colq = head * 128 + 2 * cp;
    const int kperm = (2 * cp & ~12) | ((2 * cp & 4) << 1) | ((2 * cp & 8) >> 1);
    const int vrow = ptid >> 3, vseg = ptid & 7; const unsigned vcol = head * 128 + vseg * 16;
#define GLA_BASE(n) ((n) < 8 ? 32 * (d ? 7 - (n) : (n)) : CTXL + 32 * (d ? 63 - ((n) - 8) : ((n) - 8)))
#define GLA_ROW(base, i) (b * TB + (d ? (base) + 31 - (i) : (base) + (i)))
#define GLA_LOAD(n, S) do { const int _bs = GLA_BASE(n); _Pragma("unroll") for (int i = 0; i < 8; ++i) { \
        const unsigned _o = (unsigned)GLA_ROW(_bs, 8 * qq + i) * HGW + colq; \
        lfw##S[i] = *(const unsigned*)(LF + _o); qv##S[i] = *(const unsigned*)(Qh + _o); kv##S[i] = *(const unsigned*)(KK + _o); } \
        const bf16* _vp = Vv + (unsigned)GLA_ROW(_bs, vrow) * HGW + vcol; \
        vra##S = *(const u32x4*)_vp; vrb##S = *(const u32x4*)(_vp + 8); } while (0)
#define GLA_PIN(S) do { asm volatile("" :: "v"(lfw##S[0]), "v"(lfw##S[1]), "v"(lfw##S[2]), "v"(lfw##S[3]), "v"(lfw##S[4]), "v"(lfw##S[5]), "v"(lfw##S[6]), "v"(lfw##S[7]), \
        "v"(qv##S[0]), "v"(qv##S[1]), "v"(qv##S[2]), "v"(qv##S[3]), "v"(qv##S[4]), "v"(qv##S[5]), "v"(qv##S[6]), "v"(qv##S[7]), \
        "v"(kv##S[0]), "v"(kv##S[1]), "v"(kv##S[2]), "v"(kv##S[3]), "v"(kv##S[4]), "v"(kv##S[5]), "v"(kv##S[6]), "v"(kv##S[7])); \
        asm volatile("" :: "v"(vra##S), "v"(vrb##S)); } while (0)
#define GLA_PREPA(S, par) do { f32x2 _rr = {0.f, 0.f}; const f32x2 _l2 = {L2E, L2E}; _Pragma("unroll") for (int i = 0; i < 8; ++i) { _rr = _rr + (f32x2){bflo(lfw##S[i]), bfhi(lfw##S[i])} * _l2; lf[i] = _rr; } \
        *(LAS f32x2*)(lds + TOTP + (((par) * 4 + qq) * 64 + cp) * 8) = _rr; } while (0)
#define GLA_PREPB(S, par, pbuf) do { LAS unsigned char* _B = lds + (pbuf) * BUF; const LAS unsigned char* _T = lds + TOTP + ((par) * 256 + cp) * 8; \
        const f32x2 t0 = *(const LAS f32x2*)(_T), t1 = *(const LAS f32x2*)(_T + 512), t2 = *(const LAS f32x2*)(_T + 1024), t3 = *(const LAS f32x2*)(_T + 1536); \
        const f32x2 bmid = t0 + t1, blast = bmid + (t2 + t3); const f32x2 _z = {0.f, 0.f}; \
        const f32x2 pre = qq == 0 ? _z : (qq == 1 ? t0 : (qq == 2 ? bmid : bmid + t2)); \
        const float em0 = __builtin_amdgcn_exp2f(bmid[0]), em1 = __builtin_amdgcn_exp2f(bmid[1]); \
        _Pragma("unroll") for (int i = 0; i < 8; ++i) { const float b0 = pre[0] + lf[i][0], b1 = pre[1] + lf[i][1]; \
            const float e10 = __builtin_amdgcn_exp2f(fminf(b0 - bmid[0], 100.f)), e11 = __builtin_amdgcn_exp2f(fminf(b1 - bmid[1], 100.f)); \
            const float e20 = __builtin_amdgcn_exp2f(fminf(bmid[0] - b0, 100.f)), e21 = __builtin_amdgcn_exp2f(fminf(bmid[1] - b1, 100.f)); \
            const float qm0 = bflo(qv##S[i]) * e10, qm1 = bfhi(qv##S[i]) * e11; const int _ro = (8 * qq + i) * RS; \
            *(LAS unsigned*)(_B + QM + _ro + 4 * cp) = cvtpk(qm0, qm1); *(LAS unsigned*)(_B + QS + _ro + 2 * kperm) = cvtpk(qm0 * em0, qm1 * em1); \
            *(LAS unsigned*)(_B + KM + _ro + 4 * cp) = cvtpk(bflo(kv##S[i]) * e20, bfhi(kv##S[i]) * e21); } \
        if (qq == 3) { *(LAS f32x2*)(_B + FAC + 8 * cp) = (f32x2){__builtin_amdgcn_exp2f(blast[0]), __builtin_amdgcn_exp2f(blast[1])}; \
                       *(LAS f32x2*)(_B + FAC + 512 + 8 * cp) = (f32x2){__builtin_amdgcn_exp2f(blast[0] - bmid[0]), __builtin_amdgcn_exp2f(blast[1] - bmid[1])}; } \
        *(LAS u32x4*)(_B + VI + vrow * RS + vseg * 32) = vra##S; *(LAS u32x4*)(_B + VI + vrow * RS + vseg * 32 + 16) = vrb##S; } while (0)
#define GLA_BAR() do { asm volatile("s_waitcnt lgkmcnt(0)" ::: "memory"); __builtin_amdgcn_s_barrier(); asm volatile("" ::: "memory"); } while (0)
    __syncthreads();
    if (w >= 4) {
        f32x2 lf[8]; unsigned lfw0[8], qv0[8], kv0[8], lfw1[8], qv1[8], kv1[8], lfw2[8], qv2[8], kv2[8]; u32x4 vra0, vrb0, vra1, vrb1, vra2, vrb2;
        GLA_LOAD(0, 0);
        GLA_PIN(0); GLA_LOAD(1, 1); GLA_PREPA(0, 0); GLA_BAR();
        GLA_PIN(1); GLA_LOAD(2, 2); GLA_PREPB(0, 0, 0); GLA_PREPA(1, 1); GLA_BAR();
        for (int p = 0; p < NCH; p += 3) {
            GLA_PIN(2); if (p + 3 < NCH) GLA_LOAD(p + 3, 0); if (p + 1 < NCH) GLA_PREPB(1, (p + 1) & 1, (p + 1) & 1); if (p + 2 < NCH) GLA_PREPA(2, (p + 2) & 1); GLA_BAR();
            GLA_PIN(0); if (p + 4 < NCH) GLA_LOAD(p + 4, 1); if (p + 2 < NCH) GLA_PREPB(2, (p + 2) & 1, (p + 2) & 1); if (p + 3 < NCH) GLA_PREPA(0, (p + 3) & 1); GLA_BAR();
            GLA_PIN(1); if (p + 5 < NCH) GLA_LOAD(p + 5, 2); if (p + 3 < NCH) GLA_PREPB(0, (p + 3) & 1, (p + 3) & 1); if (p + 4 < NCH) GLA_PREPA(1, (p + 4) & 1); GLA_BAR();
        }
    } else {
        f32x16 st[4];
#pragma unroll
        for (int kt = 0; kt < 4; ++kt)
#pragma unroll
            for (int i = 0; i < 16; ++i) st[kt][i] = 0.f;
        const int vt = w;
        GLA_BAR(); GLA_BAR();
        for (int n = 0; n < NCH; ++n) {
            const LAS unsigned char* B = lds + (n & 1) * BUF;
            const int base = GLA_BASE(n);
            f32x16 o, x;
#pragma unroll
            for (int i = 0; i < 16; ++i) { o[i] = 0.f; x[i] = 0.f; }
#pragma unroll
            for (int kt = 0; kt < 4; ++kt)
#pragma unroll
                for (int sx = 0; sx < 2; ++sx) {
                    const bf16x8 qa = *(const LAS bf16x8*)(B + QS + r * RS + (32 * kt + 16 * sx + 8 * h) * 2);
                    o = MFMA32(pack8(st[kt], sx), qa, o);
                }
#pragma unroll
            for (int ks = 0; ks < 8; ++ks) {
                const bf16x8 a = *(const LAS bf16x8*)(B + KM + r * RS + (16 * ks + 8 * h) * 2);
                const bf16x8 bq = *(const LAS bf16x8*)(B + QM + r * RS + (16 * ks + 8 * h) * 2);
                x = MFMA32(a, bq, x);
            }
#pragma unroll
            for (int i = 0; i < 16; ++i) x[i] = (crow(i, h) > r) ? 0.f : x[i];
#pragma unroll
            for (int sx = 0; sx < 2; ++sx) {
                const LAS unsigned char* vp = B + VI + (16 * sx + 4 * h + q4) * RS + (32 * vt + 16 * blk) * 2 + 8 * p4;
                o = MFMA32(cat8(vtr(vp), vtr(vp + 8 * RS)), pack8(x, sx), o);
            }
            bf16x8 bv[2];
#pragma unroll
            for (int ss = 0; ss < 2; ++ss) { const LAS unsigned char* vp = B + VI + (16 * ss + 8 * h + q4) * RS + (32 * vt + 16 * blk) * 2 + 8 * p4; bv[ss] = cat8(vtr(vp), vtr(vp + 4 * RS)); }
#pragma unroll
            for (int kt = 0; kt < 4; ++kt) {
                f32x16 t;
#pragma unroll
                for (int i = 0; i < 16; ++i) t[i] = 0.f;
#pragma unroll
                for (int ss = 0; ss < 2; ++ss) { const LAS unsigned char* kp = B + KM + (16 * ss + 8 * h + q4) * RS + (32 * kt + 16 * blk) * 2 + 8 * p4;
                    t = MFMA32(cat8(vtr(kp), vtr(kp + 4 * RS)), bv[ss], t); }
#pragma unroll
                for (int g4 = 0; g4 < 4; ++g4) {
                    const f32x4 dl = *(const LAS f32x4*)(B + FAC + (32 * kt + 8 * g4 + 4 * h) * 4), fl = *(const LAS f32x4*)(B + FAC + 512 + (32 * kt + 8 * g4 + 4 * h) * 4);
#pragma unroll
                    for (int e = 0; e < 4; ++e) st[kt][4 * g4 + e] = dl[e] * st[kt][4 * g4 + e] + fl[e] * t[4 * g4 + e];
                }
            }
            {
                bf16* op = Od + (size_t)GLA_ROW(base, r) * HGW + head * 128 + 32 * vt + 4 * h;
#pragma unroll
                for (int g4 = 0; g4 < 4; ++g4) { u32x2 wv; wv.x = cvtpk(o[4 * g4], o[4 * g4 + 1]); wv.y = cvtpk(o[4 * g4 + 2], o[4 * g4 + 3]); *(u32x2*)(op + 8 * g4) = wv; }
            }
            GLA_BAR();
        }
    }
    __syncthreads();
#undef GLA_BAR
#undef GLA_BASE
#undef GLA_ROW
#undef GLA_LOAD
#undef GLA_PREPA
#undef GLA_PREPB
}

DI void attn_item(LAS unsigned char* lds, int it, unsigned char* ar, const float* rpb) {
    const int tid = opaque_tid(), lane = tid & 63, w = __builtin_amdgcn_readfirstlane(tid >> 6);
    const int r = lane & 31, h = lane >> 5, blk = (lane >> 4) & 1, q4 = (lane & 15) >> 2, p4 = lane & 3;
    const bool isctx = it >= 1024;
    int b, head, rg;
    if (!isctx) { b = it >> 7; head = (it >> 3) & 15; rg = it & 7; } else { const int c = it - 1024; b = c >> 4; head = c & 15; rg = 0; }
    const bf16* Qb = (const bf16*)(ar + AR_QB); const bf16* Kb = (const bf16*)(ar + AR_KB); const bf16* Vb = (const bf16*)(ar + AR_VB); bf16* AO = (bf16*)(ar + AR_AO);
    constexpr int KS = 144, K0 = 0, V0 = 9216, K1 = 18432, V1 = 27648, RPBO = 36864;
    constexpr float L2E = 1.4426950408889634f, ATT_THR = 8.f;
    LAS float* RPBp = (LAS float*)(lds + RPBO);
    __syncthreads();
    if (!isctx) { const int dr = tid >> 5, dc = tid & 31; RPBp[tid] = (dr < 15 && dc < 31) ? rpb[head * 465 + dr * 31 + dc] * L2E : -INFINITY; }
    const int pr = w >> 2, nb = w & 3;
    const int qr = 4 * rg + 2 * pr + (r >> 4), qcol = 16 * nb + (r & 15);
    const int cst = min(max(16 * nb - 8, 0), 32);
    const int qrow = isctx ? b * TB + 32 * w + r : b * TB + CTXL + qr * 64 + qcol;
    bf16x8 qf[4];
#pragma unroll
    for (int ks = 0; ks < 4; ++ks) qf[ks] = *(const bf16x8*)(Qb + (size_t)qrow * DM + head * 64 + 16 * ks + 8 * h);
    const int rs = min(max(qr - 4, 0), 24);
    const int wr0 = 4 * rg + 2 * pr, wlo = min(max(wr0 - 4, 0), 24), whi = min(max(wr0 - 3, 0), 24) + 8;
    const int lo = isctx ? 0 : min(max(4 * rg - 4, 0), 24), hi = isctx ? 0 : min(max(4 * rg - 1, 0), 24) + 8;
    const int nloc = hi - lo, nst = nloc + 4;
    const int skey = tid >> 3, sch = tid & 7;
    const int wst = min(max(qcol - 8, 0), 48);
    int dco[16];
#pragma unroll
    for (int i = 0; i < 16; ++i) { const int kcol = cst + crow(i, h); const bool valid = (kcol >= wst) && (kcol < wst + 16); dco[i] = valid ? 4 * (kcol - qcol + 15) : 4 * 31; }
    u32x4 kA, vA, kB, vB;
#define ATT_KROW(s) ((s) < nloc ? b * TB + CTXL + (lo + (s)) * 64 + skey : b * TB + ((s) - nloc) * 64 + skey)
#define ATT_LOAD(kr, vr, s) do { const size_t _o = (size_t)ATT_KROW(s) * DM + head * 64 + sch * 8; kr = *(const u32x4*)(Kb + _o); vr = *(const u32x4*)(Vb + _o); } while (0)
#define ATT_STORE(kr, vr, buf) do { *(LAS u32x4*)(lds + ((buf) ? K1 : K0) + skey * KS + sch * 16) = kr; *(LAS u32x4*)(lds + ((buf) ? V1 : V0) + skey * KS + sch * 16) = vr; } while (0)
    float m_run = -INFINITY, l_run = 0.f;
    f32x16 o0, o1;
#pragma unroll
    for (int i = 0; i < 16; ++i) { o0[i] = 0.f; o1[i] = 0.f; }
#define ATT_XHALF(dst, src) do { float _a = (src), _b; asm volatile("s_nop 1\n\tv_mov_b32 %1, %0\n\ts_nop 1\n\tv_permlane32_swap_b32 %0, %1\n\ts_nop 1" : "+v"(_a), "=&v"(_b)); dst = _b; src = _a; } while (0)
#define ATT_QK(x, Kc, koff) do { _Pragma("unroll") for (int ks = 0; ks < 4; ++ks) { const bf16x8 a = *(const LAS bf16x8*)(lds + (Kc) + ((koff) + r) * KS + (16 * ks + 8 * h) * 2); x = MFMA32(a, qf[ks], x); } } while (0)
#define ATT_MAX16(x) fmaxf(fmaxf(fmaxf(fmaxf(x[0], x[1]), fmaxf(x[2], x[3])), fmaxf(fmaxf(x[4], x[5]), fmaxf(x[6], x[7]))), fmaxf(fmaxf(fmaxf(x[8], x[9]), fmaxf(x[10], x[11])), fmaxf(fmaxf(x[12], x[13]), fmaxf(x[14], x[15]))))
#define ATT_SHIFT(x, sh) do { const float _ns = -(sh); const f32x2 _s2 = {_ns, _ns}; _Pragma("unroll") for (int i = 0; i < 8; ++i) { f32x2 _v = {x[2 * i], x[2 * i + 1]}; _v = _v + _s2; x[2 * i] = _v[0]; x[2 * i + 1] = _v[1]; } } while (0)
#define ATT_EXP(x) do { f32x2 _p2 = {0.f, 0.f}; _Pragma("unroll") for (int i = 0; i < 8; ++i) { f32x2 _v = {__builtin_amdgcn_exp2f(x[2 * i]), __builtin_amdgcn_exp2f(x[2 * i + 1])}; x[2 * i] = _v[0]; x[2 * i + 1] = _v[1]; _p2 = _p2 + _v; } l_run += _p2[0] + _p2[1]; } while (0)
#define ATT_PV(x, Vc, koff) do { _Pragma("unroll") for (int sx = 0; sx < 2; ++sx) { \
            const bf16x8 pb = pack8(x, sx); \
            const LAS unsigned char* vp = lds + (Vc) + ((koff) + 16 * sx + 4 * h + q4) * KS + (16 * blk) * 2 + 8 * p4; \
            const bf16x8 a0 = cat8(vtr(vp), vtr(vp + 8 * KS)); \
            const bf16x8 a1 = cat8(vtr(vp + 64), vtr(vp + 64 + 8 * KS)); \
            o0 = MFMA32(a0, pb, o0); o1 = MFMA32(a1, pb, o1); } } while (0)
#define ATT_NEWMAX(tm, mu, RESHIFT) do { float _lo = (tm), _hi; ATT_XHALF(_hi, _lo); const float _mabs = fmaxf(_lo, _hi) + (mu); \
        if (__any(_mabs > m_run + ATT_THR)) { const float m_new = fmaxf(m_run, _mabs), m_use = (m_new == -INFINITY) ? 0.f : m_new; const float alpha = __builtin_amdgcn_exp2f(m_run - m_use); \
            _Pragma("unroll") for (int i = 0; i < 16; ++i) { o0[i] *= alpha; o1[i] *= alpha; } l_run *= alpha; const float _d = m_use - (mu); RESHIFT; m_run = m_new; } } while (0)
#define ATT_TILE_LOCAL(Kc, Vc, koff) do { \
        f32x16 x; \
        _Pragma("unroll") for (int i = 0; i < 16; ++i) x[i] = *(const LAS float*)(brow + dco[i]); \
        ATT_QK(x, Kc, koff); \
        const float mu = (m_run == -INFINITY) ? 0.f : m_run; \
        ATT_SHIFT(x, mu); \
        const float tm = ATT_MAX16(x); ATT_NEWMAX(tm, mu, ATT_SHIFT(x, _d)); \
        ATT_EXP(x); ATT_PV(x, Vc, koff); } while (0)
#define ATT_TILE_CTX(Kc, Vc) do { \
        f32x16 x0, x1; \
        _Pragma("unroll") for (int i = 0; i < 16; ++i) { x0[i] = 0.f; x1[i] = 0.f; } \
        ATT_QK(x0, Kc, 0); ATT_QK(x1, Kc, 32); \
        const float mu = (m_run == -INFINITY) ? 0.f : m_run; \
        ATT_SHIFT(x0, mu); ATT_SHIFT(x1, mu); \
        const float tm = fmaxf(ATT_MAX16(x0), ATT_MAX16(x1)); ATT_NEWMAX(tm, mu, do { ATT_SHIFT(x0, _d); ATT_SHIFT(x1, _d); } while (0)); \
        ATT_EXP(x0); ATT_EXP(x1); ATT_PV(x0, Vc, 0); ATT_PV(x1, Vc, 32); } while (0)
#define ATT_COMPUTE(s, Kc, Vc) do { \
        if ((s) < nloc) { const int krow = lo + (s); \
            if (krow >= wlo && krow < whi) { \
                const int dr = (krow >= rs && krow < rs + 8) ? krow - qr + 7 : 15; \
                const LAS unsigned char* brow = lds + RPBO + dr * 128; \
                ATT_TILE_LOCAL(Kc, Vc, cst); } \
        } else { ATT_TILE_CTX(Kc, Vc); } } while (0)
#define ATT_BAR() do { asm volatile("s_waitcnt lgkmcnt(0)" ::: "memory"); __builtin_amdgcn_s_barrier(); asm volatile("" ::: "memory"); } while (0)
    ATT_LOAD(kA, vA, 0); ATT_STORE(kA, vA, 0); ATT_LOAD(kA, vA, 1);
    ATT_BAR();
    for (int s = 0; s < nst; s += 2) {
        if (s + 2 < nst) ATT_LOAD(kB, vB, s + 2);
        ATT_COMPUTE(s, K0, V0);
        if (s + 1 < nst) ATT_STORE(kA, vA, 1);
        ATT_BAR();
        if (s + 1 >= nst) break;
        if (s + 3 < nst) ATT_LOAD(kA, vA, s + 3);
        ATT_COMPUTE(s + 1, K1, V1);
        if (s + 2 < nst) ATT_STORE(kB, vB, 0);
        ATT_BAR();
    }
#undef ATT_BAR
#undef ATT_COMPUTE
#undef ATT_TILE_LOCAL
#undef ATT_TILE_CTX
#undef ATT_QK
#undef ATT_MAX16
#undef ATT_NEWMAX
#undef ATT_EXP
#undef ATT_PV
    { float lo2 = l_run, hi2; ATT_XHALF(hi2, lo2); l_run = lo2 + hi2; }
#undef ATT_XHALF
    const float inv = __builtin_amdgcn_rcpf(l_run);
#pragma unroll
    for (int g4 = 0; g4 < 4; ++g4) {
        u32x2 w0; w0.x = cvtpk(o0[4 * g4] * inv, o0[4 * g4 + 1] * inv); w0.y = cvtpk(o0[4 * g4 + 2] * inv, o0[4 * g4 + 3] * inv);
        *(u32x2*)(AO + (size_t)qrow * DM + head * 64 + 8 * g4 + 4 * h) = w0;
        u32x2 w1; w1.x = cvtpk(o1[4 * g4] * inv, o1[4 * g4 + 1] * inv); w1.y = cvtpk(o1[4 * g4 + 2] * inv, o1[4 * g4 + 3] * inv);
        *(u32x2*)(AO + (size_t)qrow * DM + head * 64 + 32 + 8 * g4 + 4 * h) = w1;
    }
#undef ATT_KROW
#undef ATT_LOAD
#undef ATT_STORE
}

constexpr int NPH_PAIR = 18, NPHASE = 2 + 2 * NPH_PAIR;
__global__ void __launch_bounds__(512, 2) fwd_kernel(Ptrs P) {
    extern __shared__ __attribute__((aligned(16))) unsigned char lds_raw[];
    LAS unsigned char* lds = (LAS unsigned char*)lds_raw;
    volatile LAS unsigned* MISC = (volatile LAS unsigned*)(lds + MISC_OFF);
    const int tid = threadIdx.x;
    const int G = gridDim.x; const int bx = blockIdx.x; const int vcu = (G % 8 == 0) ? (bx % 8) * (G / 8) + bx / 8 : bx;
    unsigned char* ws = P.ws; unsigned char* ar = ws + WS_AR;
    for (int u = tid; u < (LDS_BYTES - RING_BYTES) / 4; u += 512) ((LAS unsigned*)(lds + RING_BYTES))[u] = 0u;
    __syncthreads();
    if ((tid & 63) == 0) *(volatile LAS int*)(size_t)(TIDTAB_OFF + 4 * hw_wave_slot()) = tid >> 6;
    __syncthreads();
    const int lo = P.ph_lo, hi = P.ph_hi;
    XcdBarrier bar; bar.bar = (unsigned*)(ws + WS_CTL) + CW_BAR; bar.x = 0; bar.st = nullptr;
    if (hi - lo > 1) bar = xcd_barrier_post((unsigned*)(ws + WS_CTL) + CW_BAR, MISC + 8);
#ifndef PH_EN
#define PH_EN 0xFFFFFu
#endif
#define EN(id) (((PH_EN) >> (id)) & 1u)
#ifndef PH_REP
#define PH_REP 0u
#endif
#define REPS(id) (1 + (int)(((PH_REP) >> (id)) & 1u))
#define IN(k) (lo <= (k) && (k) < hi)
#define SEAM(k) do { if ((k) + 1 < hi) xcd_barrier(bar); } while (0)
    const bool grp = (G == 256) && (hi - lo > 1); unsigned gbn = 0u; unsigned* gcnt = (unsigned*)(ws + WS_CTL) + CW_GRP + 64 * (bx & 7);
#define GSEAM(k) do { if ((k) + 1 < hi) { if (lgrp) xcc_local_barrier(lbw, (unsigned)(bx & 7), 32u); else xcd_barrier(bar); } } while (0)
    const float* MOD = (const float*)(ws + WS_MOD);
    const bf16* U = (const bf16*)(ws + WS_U);
    const int* TILE = (const int*)(ws + WS_CTL) + CW_TILE;

    unsigned* lbw = (unsigned*)(ws + WS_CTL) + CW_LB;
    if (grp && opaque_tid() == 0 && xb_xcc_id() != (unsigned)(bx & 7)) (void)xb_add(&lbw[2048], 1u);
    if (EN(0) && IN(0)) for (int rep = 0; rep < REPS(0); ++rep) { prologue_phase(P, lds, vcu, G); SEAM(0); }
    const bool lgrp = grp && lo == 0 && (xb_ld(&lbw[2048]) == 0u);


    for (int j = 0; j < 2; ++j) {
        const int pb = 1 + NPH_PAIR * j, LE = 2 * j, LO = 2 * j + 1;
        if (EN(1) && IN(pb + 0)) for (int rep = 0; rep < REPS(1); ++rep) { if (j == 0) norm_phase<false, true>(P, vcu, G, LE, 0, false, false, 0, false); else norm_phase<false, false>(P, vcu, G, LE, 0, true, false, 0, false); GSEAM(pb + 0); }
        if (EN(2) && IN(pb + 1)) for (int rep = 0; rep < REPS(2); ++rep) {
            Gemm g{U, (const bf16*)(ws + WS_WIN) + (size_t)j * EVIN * DM, DM, DM, DM}; GOrder S; S.init(T / 256, EVIN / 256, G, bx, 0, nullptr); S.chunk = grp;
            EpiEvenIn E{ar, (const float*)(ws + WS_LBT) + (size_t)j * 2 * 3 * 512};
            pg8::gemm_phase<EpiEvenIn>(lds, g, S, E); SEAM(pb + 1);
        }
        const bool fusedmix = (G == 256) && (hi - lo > 1);
        if (EN(3) && IN(pb + 2) && !fusedmix) for (int rep = 0; rep < REPS(3); ++rep) { conv_phase(P, vcu, G, j); SEAM(pb + 2); }
        if (EN(4) && IN(pb + 3) && !fusedmix) for (int rep = 0; rep < REPS(4); ++rep) {
            Gemm g{(const bf16*)(ar + AR_XC), (const bf16*)(ws + WS_WG) + (size_t)j * 2048 * 256, HGW, 256, 256}; GOrder S; S.init(T / 256, 8, G, bx, 3, nullptr);
            EpiGate E{ar, P.in[I_BA] + (size_t)j * 1024, P.in[I_BX] + (size_t)j * 1024};
            pg8::gemm_phase<EpiGate>(lds, g, S, E); SEAM(pb + 3);
        }
        if (EN(5) && IN(pb + 4)) for (int rep = 0; rep < REPS(5); ++rep) {
            const float* lslp = (const float*)(ws + WS_LBT + 65536) + (size_t)j * 1024;
            if (fusedmix) {
                if (vcu < 64) gla_item(lds, vcu, ar);
                else {
                    unsigned* sc = (unsigned*)(ws + WS_CTL) + CW_SUB;
                    conv_phase(P, vcu - 64, 192, j);
                    sub_barrier(sc, 192u * (unsigned)(2 * j + 1));
                    {
                        Gemm g{(const bf16*)(ar + AR_XC), (const bf16*)(ws + WS_WG) + (size_t)j * 2048 * 256, HGW, 256, 256}; GOrder S; S.init(T / 256, 8, 192, vcu - 64, 3, nullptr);
                        EpiGate E{ar, P.in[I_BA] + (size_t)j * 1024, P.in[I_BX] + (size_t)j * 1024};
                        pg8::gemm_phase<EpiGate>(lds, g, S, E);
                    }
                    sub_barrier(sc, 192u * (unsigned)(2 * j + 2));
                    if (vcu < 192) rgscan_item(lds, vcu - 64, ar, lslp);
                    else moe_convert_queue(P, lds, j, 5);
                }
            } else {
                for (int it = vcu; it < 192; it += G) { if (it < 64) gla_item(lds, it, ar); else rgscan_item(lds, it - 64, ar, lslp); }
                if (rep == 0 && vcu >= 64) moe_convert_queue(P, lds, j, vcu >= 192 ? 3 : 1);
            }
            SEAM(pb + 4);
        }
        if (EN(6) && IN(pb + 5)) for (int rep = 0; rep < REPS(6); ++rep) { merge_phase(P, vcu, G, j); SEAM(pb + 5); }
        if (EN(7) && IN(pb + 6)) for (int rep = 0; rep < REPS(7); ++rep) {
            Gemm g{(const bf16*)(ar + AR_MIX), (const bf16*)(ws + WS_WOUT) + (size_t)j * DM * DM, DM, DM, DM}; GOrder S; S.init(T / 256, 4, G, bx, 0, nullptr); S.chunk = grp;
            EpiResid E{(bf16*)(ws + WS_D), MOD + (size_t)(LE * 9) * 6144 + 2 * 1024};
            pg8::gemm_phase<EpiResid>(lds, g, S, E);
            if (rep == 0 && bx >= 32) moe_convert_queue(P, lds, j, 1);
            GSEAM(pb + 6);
        }
        if (EN(8) && IN(pb + 7)) for (int rep = 0; rep < REPS(8); ++rep) { norm_phase<false, false>(P, vcu, G, LE, 1, false, false, 0, true); GSEAM(pb + 7); }
        const int nun13 = (T / 256) * (2 * DFF / 256), nfull13 = nun13 / G, ntail13 = nun13 - nfull13 * G;
        const bool fusetail = (G == 256) && (hi - lo > 1) && ntail13 > 0;
        if (EN(9) && IN(pb + 8)) for (int rep = 0; rep < REPS(9); ++rep) {
            Gemm g{U, (const bf16*)(ws + WS_W13) + (size_t)j * 2 * DFF * DM, DM, DM, DM}; GOrder S; S.init(T / 256, 2 * DFF / 256, G, bx, 0, nullptr); if (fusetail) { S.imax = nfull13; S.chunk = true; }
            EpiSwiglu E{(bf16*)(ar + AR_HID), DFF};
            pg8::gemm_phase<EpiSwiglu>(lds, g, S, E); GSEAM(pb + 8);
        }
        if (EN(10) && IN(pb + 9)) for (int rep = 0; rep < REPS(10); ++rep) {
            unsigned* tc = (unsigned*)(ws + WS_CTL) + (lgrp ? CW_TAILG + 64 * (bx & 7) : CW_TAIL);
            const int chalf = !fusetail ? bx : (bx < G - 64 ? -1 : (lgrp ? 2 * (4 * (bx & 7) + (((bx - (G - 64)) >> 3) >> 1)) + (((bx - (G - 64)) >> 3) & 1) : bx - (G - 64)));
            int wfull = 0, whalf = 0;
            if (fusetail) {
                int pmf = -1, pmh = -1;
                { GOrder S; S.init(64, 4, G, bx, 1, nullptr); pg8::Unit u; if (S.next(0, u)) pmf = u.pm; }
                { GOrder S; S.init(8, 4, G, chalf, 4, nullptr); S.P = 2; S.Kp = DFF / 2; pg8::Unit u; if (S.next(0, u)) pmh = u.pm; }
                for (int k = 0; k < ntail13; ++k) { GOrder S; S.init(T / 256, 2 * DFF / 256, G, k, 0, nullptr); S.i0 = nfull13; S.chunk = true; pg8::Unit u; if (S.next(0, u)) { wfull |= (u.pm == pmf) ? 1 : 0; whalf |= (u.pm == pmh) ? 1 : 0; } }
                wfull = __builtin_amdgcn_readfirstlane(wfull); whalf = __builtin_amdgcn_readfirstlane(whalf);
                if (bx < ntail13) {
                    Gemm g{U, (const bf16*)(ws + WS_W13) + (size_t)j * 2 * DFF * DM, DM, DM, DM}; GOrder S; S.init(T / 256, 2 * DFF / 256, G, bx, 0, nullptr); S.i0 = nfull13; S.imax = 1; S.chunk = true;
                    EpiSwiglu E{(bf16*)(ar + AR_HID), DFF};
                    pg8::gemm_phase<EpiSwiglu>(lds, g, S, E);
                    tail_signal(tc);
                }
            }
            const unsigned ttarget = (unsigned)(lgrp ? ntail13 / 8 : ntail13) * (unsigned)(j + 1);
            {
                Gemm g{(const bf16*)(ar + AR_HID), (const bf16*)(ws + WS_W2) + (size_t)j * DM * DFF, DFF, DFF, DFF}; GOrder S; S.init(64, 4, G, bx, 1, nullptr);
                EpiResid E{(bf16*)(ws + WS_D), MOD + (size_t)(LE * 9) * 6144 + 5 * 1024};
                if (wfull) tail_wait(tc, ttarget);
                pg8::gemm_phase<EpiResid>(lds, g, S, E);
            }
            {
                Gemm g{(const bf16*)(ar + AR_HID), (const bf16*)(ws + WS_W2) + (size_t)j * DM * DFF, DFF, DFF, DFF / 2}; GOrder S; S.init(8, 4, G, chalf, 4, nullptr); S.P = 2; S.Kp = DFF / 2;
                EpiResidPart E{(bf16*)(ws + WS_D), MOD + (size_t)(LE * 9) * 6144 + 5 * 1024, (float*)(ws + WS_PART)};
                if (whalf) tail_wait(tc, ttarget);
                pg8::gemm_phase<EpiResidPart>(lds, g, S, E);
            }
            if (rep == 0 && (fusetail ? (bx >= 64 && bx < G - 64) : bx >= 64)) moe_convert_queue(P, lds, j, 2);
            GSEAM(pb + 9);
        }
        const bool lastl = (j == 1);
        if (EN(11) && IN(pb + 10)) for (int rep = 0; rep < REPS(11); ++rep) { norm_phase<false, false>(P, vcu, G, LO, 0, false, false, 1, true); SEAM(pb + 10); }
        if (EN(12) && IN(pb + 11)) for (int rep = 0; rep < REPS(12); ++rep) {
            Gemm g{U, (const bf16*)(ws + WS_WQKV) + (size_t)j * 3 * DM * DM, DM, DM, DM}; GOrder S; S.init(T / 256, 12, G, bx, 0, nullptr); S.chunk = grp;
            EpiQKV E{ar, P.in[I_QG] + j * 64, P.in[I_KG] + j * 64};
            pg8::gemm_phase<EpiQKV>(lds, g, S, E); GSEAM(pb + 11);
        }
        if (EN(13) && IN(pb + 12)) for (int rep = 0; rep < REPS(13); ++rep) {
            {
                const int nit = lastl ? 1024 : 1152;
                for (int k = 0; k < 5; ++k) {
                    int it = vcu + 256 * k;
                    if (lgrp) it = k < 4 ? (((vcu >> 5) << 7) | (((vcu >> 1) & 15) << 3) | (2 * k + (vcu & 1))) : ((vcu & 31) < 16 ? 1024 + 16 * (vcu >> 5) + (vcu & 31) : nit);
                    if (it >= nit) break;
                    attn_item(lds, it, ar, P.in[I_RPB] + (size_t)j * 16 * 465);
                }
            }
            GSEAM(pb + 12);
        }
        if (EN(14) && IN(pb + 13)) for (int rep = 0; rep < REPS(14); ++rep) {
            Gemm g{(const bf16*)(ar + AR_AO), (const bf16*)(ws + WS_WO) + (size_t)j * DM * DM, DM, DM, DM}; GOrder S; S.init(lastl ? 64 : 72, 4, G, bx, lastl ? 1 : 0, nullptr); S.chunk = grp;
            EpiResid E{(bf16*)(ws + WS_D), MOD + (size_t)(LO * 9) * 6144 + 2 * 1024};
            pg8::gemm_phase<EpiResid>(lds, g, S, E);
            if (rep == 0 && !lastl && bx >= 32) moe_convert_queue(P, lds, j, 1);
            GSEAM(pb + 13);
        }
        if (EN(15) && IN(pb + 14)) for (int rep = 0; rep < REPS(15); ++rep) { norm_phase<true, false>(P, vcu, G, LO, 1, false, lastl, 0, true); SEAM(pb + 14); }
        if (EN(16) && IN(pb + 15)) for (int rep = 0; rep < REPS(16); ++rep) { dispatch_phase(P, lds, vcu, G, lastl); if (rep == 0) moe_convert_queue(P, lds, j, 1 << 20); SEAM(pb + 15); }
        if (EN(17) && IN(pb + 16)) for (int rep = 0; rep < REPS(17); ++rep) {
            const int ntile = __builtin_amdgcn_readfirstlane(TILE[160]);
            Gemm g{(const bf16*)(ar + AR_UG), (const bf16*)(ws + WS_MW13), DM, DM, DM}; GOrder S; S.init(ntile, 2 * DFF / 256, G, bx, 2, TILE);
            EpiSwiglu E{(bf16*)(ar + AR_HM), DFF};
            pg8::gemm_phase<EpiSwiglu>(lds, g, S, E); SEAM(pb + 16);
        }
        if (EN(18) && IN(pb + 17)) for (int rep = 0; rep < REPS(18); ++rep) {
            const int ntile = __builtin_amdgcn_readfirstlane(TILE[160]);
            const int nun = 4 * ntile, Ffull = (nun / G) * G, tl = nun - Ffull;
            const bool split = (G == 256) && tl > 0 && tl <= 128 && Ffull > 0;
            {
                Gemm g{(const bf16*)(ar + AR_HM), (const bf16*)(ws + WS_MW2), DFF, DFF, DFF}; GOrder S; S.init(ntile, 4, G, bx, 2, TILE); if (split) S.imax = Ffull / G;
                EpiBf16 E{(bf16*)(ar + AR_Y32), DM};
                pg8::gemm_phase<EpiBf16>(lds, g, S, E);
            }
            if (split) {
                Gemm g{(const bf16*)(ar + AR_HM), (const bf16*)(ws + WS_MW2), DFF, DFF, DFF / 2}; GOrder S; S.init(ntile, 4, G, bx, 6, TILE); S.F = Ffull; S.tail = tl; S.Kp = DFF / 2;
                EpiMoeTail E{(bf16*)(ar + AR_Y32), (bf16*)(ws + WS_PART), (unsigned*)(ws + WS_CTL) + CW_YF + 1024 * j};
                pg8::gemm_phase<EpiMoeTail>(lds, g, S, E);
            }
            SEAM(pb + 17);
        }
    }
    if (EN(19) && IN(NPHASE - 1)) final_phase(P, vcu, G);
#undef IN
#undef SEAM
}

extern "C" void kernel_launch(void* const* d_in, const int* in_sizes, int n_in, void* d_out, int out_size, void* d_ws, size_t ws_size, hipStream_t stream) {
    static int grid = 0;
    if (grid == 0) {
        if (n_in != 31 || out_size != NBATCH * SEQ * DM || ws_size < WS_END) { fprintf(stderr, "kernel_launch: unexpected problem: n_in %d out %d ws %zu (need %zu)\n", n_in, out_size, ws_size, (size_t)WS_END); grid = -1; return; }
        int dev = 0, cus = 0;
        if (hipGetDevice(&dev) != hipSuccess || hipDeviceGetAttribute(&cus, hipDeviceAttributeMultiprocessorCount, dev) != hipSuccess) { grid = -1; return; }
        if (hipFuncSetAttribute((const void*)fwd_kernel, hipFuncAttributeMaxDynamicSharedMemorySize, LDS_BYTES) != hipSuccess) { fprintf(stderr, "kernel_launch: hipFuncSetAttribute failed\n"); grid = -1; return; }
        int per_cu = 0;
        if (hipOccupancyMaxActiveBlocksPerMultiprocessor(&per_cu, (const void*)fwd_kernel, 512, LDS_BYTES) != hipSuccess || per_cu < 1) { fprintf(stderr, "kernel_launch: occupancy query reports %d blocks per CU\n", per_cu); }
        (void)hipGetLastError();
        grid = cus;
    }
    if (grid < 0) return;
    (void)hipMemsetAsync((char*)d_ws + WS_CTL, 0, CTL_ZERO_BYTES, stream);
    Ptrs p{};
    for (int i = 0; i < 31; ++i) p.in[i] = (const float*)d_in[i];
    p.out = (float*)d_out; p.ws = (unsigned char*)d_ws;
#if MK_SPLIT
    for (int k = 0; k < NPHASE; ++k) { p.ph_lo = k; p.ph_hi = k + 1; hipLaunchKernelGGL(fwd_kernel, dim3(grid), dim3(512), LDS_BYTES, stream, p); }
#else
    p.ph_lo = 0; p.ph_hi = NPHASE;
    hipLaunchKernelGGL(fwd_kernel, dim3(grid), dim3(512), LDS_BYTES, stream, p);
#endif
}
```
